# Optimizing an MI355X kernel written in HIP

```python
import jax, jax.numpy as jnp
from jax import lax
import numpy as np

D_MODEL = 2048
BATCH = 1
SEQ = 8192
DEPTH = 1

CHUNK = 64
D_MIX = D_MODEL
D_CONV = D_MIX // 2
D_ATT = D_MIX - D_CONV
HEAD_DIM = 64
N_HEADS = D_ATT // HEAD_DIM
LEFT_CHUNKS = 8
BAND = (LEFT_CHUNKS + 1) * CHUNK
REL_CLIP = 128
N_REL = 2 * REL_CLIP + 1
CONV_WIDTH = 31
N_GROUPS = 8
EXPERTS_PER_GROUP = 8
N_EXPERTS = N_GROUPS * EXPERTS_PER_GROUP
TOP_K = 2
D_EXPERT = D_MODEL // 4
BLOCK_ROWS = 128
D_IN = 2 * D_CONV + 3 * D_ATT
RMS_EPS = 1e-6
LN_EPS = 1e-5
NEG_INF = -1e30

kernel_name = "hybrid_conv_chunkattn_hiermoe_block"


def rmsnorm(x, g):
    xf = x.astype(jnp.float32)
    y = xf * lax.rsqrt(jnp.mean(xf * xf, axis=-1, keepdims=True) + RMS_EPS)
    return (y * g.astype(jnp.float32)).astype(x.dtype)


def conv_module(a, gate, w_dw, b_dw, ln_g, ln_b):
    u = a * jax.nn.sigmoid(gate)
    u = lax.conv_general_dilated(
        u, w_dw.astype(u.dtype), window_strides=(1,),
        padding=((CONV_WIDTH - 1, 0),),
        dimension_numbers=("NWC", "WIO", "NWC"),
        feature_group_count=D_CONV) + b_dw.astype(u.dtype)
    uf = u.astype(jnp.float32)
    mu = jnp.mean(uf, axis=-1, keepdims=True)
    var = jnp.mean(jnp.square(uf - mu), axis=-1, keepdims=True)
    un = (uf - mu) * lax.rsqrt(var + LN_EPS) * ln_g.astype(jnp.float32) + ln_b.astype(jnp.float32)
    return jax.nn.silu(un).astype(a.dtype)


def chunk_band(t, nc):
    b = t.shape[0]
    t = jnp.pad(t, ((0, 0), (LEFT_CHUNKS * CHUNK, 0), (0, 0), (0, 0)))
    t = t.reshape(b, nc + LEFT_CHUNKS, CHUNK, N_HEADS, HEAD_DIM)
    return jnp.concatenate([t[:, i:i + nc] for i in range(LEFT_CHUNKS + 1)], axis=2)


def chunk_attention(q, k, v, rel_table):
    b, s, _ = q.shape
    nc = s // CHUNK
    qc = q.reshape(b, nc, CHUNK, N_HEADS, HEAD_DIM)
    kb = chunk_band(k.reshape(b, s, N_HEADS, HEAD_DIM), nc)
    vb = chunk_band(v.reshape(b, s, N_HEADS, HEAD_DIM), nc)
    scores = jnp.einsum("bcqhd,bckhd->bchqk", qc, kb,
                        preferred_element_type=jnp.float32) * (HEAD_DIM ** -0.5)
    qi = jnp.arange(CHUNK)[:, None]
    kj = jnp.arange(BAND)[None, :]
    rel = jnp.clip(LEFT_CHUNKS * CHUNK + qi - kj, -REL_CLIP, REL_CLIP) + REL_CLIP
    bias = rel_table.astype(jnp.float32)[:, rel]
    kpos = (jnp.arange(nc)[:, None] * CHUNK - LEFT_CHUNKS * CHUNK
            + jnp.arange(BAND)[None, :])
    valid = (kpos >= 0)[None, :, None, None, :]
    scores = jnp.where(valid, scores + bias[None, None], NEG_INF)
    p = jax.nn.softmax(scores, axis=-1).astype(v.dtype)
    o = jnp.einsum("bchqk,bckhd->bcqhd", p, vb)
    return o.reshape(b, s, D_ATT)


def hier_moe(h, w_group, b_group, w_expert_router, b_expert_router, w_gate, w_up, w_down):
    b, s, d = h.shape
    n = b * s
    t = h.reshape(n, d)
    g_logits = jnp.matmul(t, w_group, preferred_element_type=jnp.float32) + b_group.astype(jnp.float32)
    g_prob = jax.nn.softmax(g_logits, axis=-1)
    grp = jnp.argmax(g_logits, axis=-1)
    p_grp = jnp.take_along_axis(g_prob, grp[:, None], axis=1)
    e_logits = (jnp.matmul(t, w_expert_router, preferred_element_type=jnp.float32)
                + b_expert_router.astype(jnp.float32)).reshape(n, N_GROUPS, EXPERTS_PER_GROUP)
    e_logits_g = jnp.take_along_axis(e_logits, grp[:, None, None], axis=1)[:, 0]
    top_v, top_i = lax.top_k(e_logits_g, TOP_K)
    gates = jax.nn.softmax(top_v, axis=-1) * p_grp
    expert = grp[:, None] * EXPERTS_PER_GROUP + top_i

    m = n * TOP_K
    e_flat = expert.reshape(m)
    tok = jnp.repeat(jnp.arange(n, dtype=jnp.int32), TOP_K)
    g_flat = gates.reshape(m)
    order = jnp.argsort(e_flat)
    e_s, tok_s, g_s = e_flat[order], tok[order], g_flat[order]
    counts = jax.ops.segment_sum(jnp.ones((m,), jnp.int32), e_flat, num_segments=N_EXPERTS)
    starts = jnp.cumsum(counts) - counts
    pcounts = (counts + BLOCK_ROWS - 1) // BLOCK_ROWS * BLOCK_ROWS
    pends = jnp.cumsum(pcounts)
    pstarts = pends - pcounts
    dest = pstarts[e_s] + jnp.arange(m, dtype=jnp.int32) - starts[e_s]
    n_blocks = -(-m // BLOCK_ROWS) + N_EXPERTS
    rows = n_blocks * BLOCK_ROWS
    row_tok = jnp.zeros((rows,), jnp.int32).at[dest].set(tok_s)
    row_gate = jnp.zeros((rows,), jnp.float32).at[dest].set(g_s)
    block_exp = jnp.minimum(
        jnp.searchsorted(pends, jnp.arange(n_blocks, dtype=jnp.int32) * BLOCK_ROWS, side="right"),
        N_EXPERTS - 1)
    xb = t[row_tok].reshape(n_blocks, BLOCK_ROWS, d)

    def expert_block(args):
        xe, e = args
        a = xe @ w_gate[e]
        u = xe @ w_up[e]
        return (jax.nn.silu(a) * u) @ w_down[e]

    yb = lax.map(expert_block, (xb, block_exp))
    y = yb.reshape(rows, d).astype(jnp.float32) * row_gate[:, None]
    out = jax.ops.segment_sum(y, row_tok, num_segments=n)
    return out.reshape(b, s, d).astype(h.dtype)


def setup_inputs(seed: int = 0) -> dict:
    key = jax.random.key(seed)
    ks = jax.random.split(key, 20)
    f32 = jnp.float32
    nrm = lambda k, shape, scale: jax.random.normal(k, shape, f32) * scale
    return {
        "x": nrm(ks[0], (BATCH, SEQ, D_MODEL), 1.0),
        "norm1_g": 1.0 + nrm(ks[1], (DEPTH, D_MODEL), 0.02),
        "w_in": nrm(ks[2], (DEPTH, D_MODEL, D_IN), D_MODEL ** -0.5),
        "w_dw": nrm(ks[3], (DEPTH, CONV_WIDTH, 1, D_CONV), CONV_WIDTH ** -0.5),
        "b_dw": nrm(ks[4], (DEPTH, D_CONV), 0.01),
        "ln_g": 1.0 + nrm(ks[5], (DEPTH, D_CONV), 0.02),
        "ln_b": nrm(ks[6], (DEPTH, D_CONV), 0.01),
        "rel_bias": nrm(ks[7], (DEPTH, N_HEADS, N_REL), 0.5),
        "w_out": nrm(ks[8], (DEPTH, D_MIX, D_MODEL), D_MIX ** -0.5),
        "norm2_g": 1.0 + nrm(ks[9], (DEPTH, D_MODEL), 0.02),
        "w_group": nrm(ks[10], (DEPTH, D_MODEL, N_GROUPS), D_MODEL ** -0.5),
        "b_group": nrm(ks[11], (DEPTH, N_GROUPS), 0.01),
        "w_expert_router": nrm(ks[12], (DEPTH, D_MODEL, N_EXPERTS), D_MODEL ** -0.5),
        "b_expert_router": nrm(ks[13], (DEPTH, N_EXPERTS), 0.01),
        "w_gate": nrm(ks[14], (DEPTH, N_EXPERTS, D_MODEL, D_EXPERT), D_MODEL ** -0.5),
        "w_up": nrm(ks[15], (DEPTH, N_EXPERTS, D_MODEL, D_EXPERT), D_MODEL ** -0.5),
        "w_down": nrm(ks[16], (DEPTH, N_EXPERTS, D_EXPERT, D_MODEL), D_EXPERT ** -0.5),
        "final_g": 1.0 + nrm(ks[17], (D_MODEL,), 0.02),
    }


def reference(x, norm1_g, w_in, w_dw, b_dw, ln_g, ln_b, rel_bias, w_out, norm2_g,
              w_group, b_group, w_expert_router, b_expert_router, w_gate, w_up, w_down,
              final_g):
    for l in range(DEPTH):
        h = rmsnorm(x, norm1_g[l])
        p = jnp.matmul(h, w_in[l])
        c_val = p[..., :D_CONV]
        c_gate = p[..., D_CONV:2 * D_CONV]
        q = p[..., 2 * D_CONV:2 * D_CONV + D_ATT]
        k = p[..., 2 * D_CONV + D_ATT:2 * D_CONV + 2 * D_ATT]
        v = p[..., 2 * D_CONV + 2 * D_ATT:]
        conv_out = conv_module(c_val, c_gate, w_dw[l], b_dw[l], ln_g[l], ln_b[l])
        attn_out = chunk_attention(q, k, v, rel_bias[l])
        mixed = jnp.concatenate([conv_out, attn_out.astype(conv_out.dtype)], axis=-1)
        x = x + jnp.matmul(mixed, w_out[l]).astype(x.dtype)
        h2 = rmsnorm(x, norm2_g[l])
        x = x + hier_moe(h2, w_group[l], b_group[l], w_expert_router[l], b_expert_router[l],
                         w_gate[l], w_up[l], w_down[l]).astype(x.dtype)
    return rmsnorm(x, final_g)
```

```cpp
#include <hip/hip_runtime.h>
#include <stdint.h>

constexpr int DM = 2048, SEQ = 8192, DCONV = 1024, DATT = 1024, HD = 64, NH = 16, DIN = 5120;
constexpr int CHUNK = 64, LEFT = 8, BAND = 576, RCLIP = 128, NREL = 257, CW = 31;
constexpr int NG = 8, EPG = 8, NE = 64, DE = 512;
constexpr int LCAP = 8192;

constexpr size_t MiB = 1ull << 20;
constexpr size_t WS_CTL = 0;
constexpr size_t WS_LTK = 1 * MiB;
constexpr size_t WS_LGT = 3 * MiB;
constexpr size_t WS_H = 8 * MiB;
constexpr size_t WS_P = 72 * MiB;
constexpr size_t WS_MIX = 232 * MiB;
constexpr size_t WS_X1 = 296 * MiB;
constexpr size_t WS_G = 360 * MiB;
constexpr size_t WS_Y = 424 * MiB;
constexpr size_t WS_END = 552 * MiB;

__device__ __forceinline__ float wave_sum(float v) {
#pragma unroll
    for (int o = 1; o < 64; o <<= 1) v += __shfl_xor(v, o);
    return v;
}
__device__ __forceinline__ float wave_max(float v) {
#pragma unroll
    for (int o = 1; o < 64; o <<= 1) v = fmaxf(v, __shfl_xor(v, o));
    return v;
}
__device__ __forceinline__ float sigmoidf_(float x) { return 1.f / (1.f + __expf(-x)); }

template <class AL, class BL, class EP>
__device__ __forceinline__ void gemm64_f32(int K, AL aload, BL bload, EP epi) {
    __shared__ float As[16][68];
    __shared__ float Bs[16][64];
    const int tid = threadIdx.x, ty = tid >> 4, tx = tid & 15;
    float acc[4][4];
#pragma unroll
    for (int i = 0; i < 4; ++i)
#pragma unroll
        for (int j = 0; j < 4; ++j) acc[i][j] = 0.f;
    const int am = tid >> 2, ak = (tid & 3) * 4;
    const int bk = tid >> 4, bn = (tid & 15) * 4;
    for (int k0 = 0; k0 < K; k0 += 16) {
        const float4 a = aload(am, k0 + ak);
        const float4 b = bload(k0 + bk, bn);
        __syncthreads();
        As[ak + 0][am] = a.x; As[ak + 1][am] = a.y; As[ak + 2][am] = a.z; As[ak + 3][am] = a.w;
        *(float4*)&Bs[bk][bn] = b;
        __syncthreads();
#pragma unroll
        for (int kk = 0; kk < 16; ++kk) {
            const float4 av = *(const float4*)&As[kk][ty * 4];
            const float4 bv = *(const float4*)&Bs[kk][tx * 4];
            const float aa[4] = {av.x, av.y, av.z, av.w};
            const float bb[4] = {bv.x, bv.y, bv.z, bv.w};
#pragma unroll
            for (int i = 0; i < 4; ++i)
#pragma unroll
                for (int j = 0; j < 4; ++j) acc[i][j] += aa[i] * bb[j];
        }
    }
#pragma unroll
    for (int i = 0; i < 4; ++i) epi(ty * 4 + i, tx * 4, make_float4(acc[i][0], acc[i][1], acc[i][2], acc[i][3]));
}

__global__ void __launch_bounds__(256) k_rmsnorm(const float* __restrict__ x, const float* __restrict__ g, float* __restrict__ out) {
    const int row = blockIdx.x * 4 + (threadIdx.x >> 6), lane = threadIdx.x & 63;
    const float* xr = x + (size_t)row * DM;
    float ss = 0.f;
    for (int i = 0; i < 32; ++i) { const float v = xr[lane + 64 * i]; ss += v * v; }
    ss = wave_sum(ss);
    const float rstd = rsqrtf(ss * (1.f / DM) + 1e-6f);
    for (int i = 0; i < 32; ++i) { const int k = lane + 64 * i; out[(size_t)row * DM + k] = xr[k] * rstd * g[k]; }
}

__global__ void __launch_bounds__(256) k_gemm_in(const float* __restrict__ h, const float* __restrict__ w, float* __restrict__ P) {
    const int n0 = blockIdx.x * 64, m0 = blockIdx.y * 64;
    gemm64_f32(DM,
        [&](int m, int k) { return *(const float4*)&h[(size_t)(m0 + m) * DM + k]; },
        [&](int k, int n) { return *(const float4*)&w[(size_t)k * DIN + n0 + n]; },
        [&](int m, int n, float4 v) { *(float4*)&P[(size_t)(m0 + m) * DIN + n0 + n] = v; });
}

__global__ void __launch_bounds__(256) k_conv(const float* __restrict__ P, const float* __restrict__ wdw, const float* __restrict__ bdw,
                                               const float* __restrict__ lng, const float* __restrict__ lnb, float* __restrict__ mixed) {
    __shared__ float red[8];
    const int t = blockIdx.x, tid = threadIdx.x;
    float o[4];
#pragma unroll
    for (int q = 0; q < 4; ++q) {
        const int c = tid + 256 * q;
        float acc = bdw[c];
        for (int j = 0; j < CW; ++j) {
            const int tt = t - (CW - 1) + j;
            if (tt >= 0) {
                const float a = P[(size_t)tt * DIN + c], gt = P[(size_t)tt * DIN + DCONV + c];
                acc += a * sigmoidf_(gt) * wdw[j * DCONV + c];
            }
        }
        o[q] = acc;
    }
    float s = o[0] + o[1] + o[2] + o[3];
    s = wave_sum(s);
    if ((tid & 63) == 0) red[tid >> 6] = s;
    __syncthreads();
    const float mu = (red[0] + red[1] + red[2] + red[3]) * (1.f / DCONV);
    float q2 = 0.f;
#pragma unroll
    for (int q = 0; q < 4; ++q) { const float d = o[q] - mu; q2 += d * d; }
    q2 = wave_sum(q2);
    if ((tid & 63) == 0) red[4 + (tid >> 6)] = q2;
    __syncthreads();
    const float var = (red[4] + red[5] + red[6] + red[7]) * (1.f / DCONV);
    const float rstd = rsqrtf(var + 1e-5f);
#pragma unroll
    for (int q = 0; q < 4; ++q) {
        const int c = tid + 256 * q;
        const float un = (o[q] - mu) * rstd * lng[c] + lnb[c];
        mixed[(size_t)t * DM + c] = un * sigmoidf_(un);
    }
}

__global__ void __launch_bounds__(256) k_attn(const float* __restrict__ P, const float* __restrict__ relb, float* __restrict__ mixed) {
    const int t = blockIdx.x, h = blockIdx.y * 4 + (threadIdx.x >> 6), lane = threadIdx.x & 63;
    const int c = t >> 6, i = t & 63;
    const float qd = P[(size_t)t * DIN + 2048 + h * HD + lane];
    float sc[9];
#pragma unroll
    for (int s = 0; s < 9; ++s) {
        const int ch = c - LEFT + s;
        float v = -1e30f;
        if (ch >= 0) {
            const int kpos = ch * 64 + lane;
            const float* kr = P + (size_t)kpos * DIN + 3072 + h * HD;
            float acc = 0.f;
            for (int d = 0; d < HD; d += 4) {
                const float4 kk = *(const float4*)&kr[d];
                acc += __shfl(qd, d) * kk.x + __shfl(qd, d + 1) * kk.y + __shfl(qd, d + 2) * kk.z + __shfl(qd, d + 3) * kk.w;
            }
            const int j = s * 64 + lane;
            int rel = LEFT * CHUNK + i - j; rel = rel < -RCLIP ? -RCLIP : (rel > RCLIP ? RCLIP : rel);
            v = acc * 0.125f + relb[h * NREL + rel + RCLIP];
        }
        sc[s] = v;
    }
    float m = sc[0];
#pragma unroll
    for (int s = 1; s < 9; ++s) m = fmaxf(m, sc[s]);
    m = wave_max(m);
    float l = 0.f;
#pragma unroll
    for (int s = 0; s < 9; ++s) { const int ch = c - LEFT + s; sc[s] = (ch >= 0) ? __expf(sc[s] - m) : 0.f; l += sc[s]; }
    l = wave_sum(l);
    float o = 0.f;
#pragma unroll
    for (int s = 0; s < 9; ++s) {
        const int ch = c - LEFT + s;
        if (ch >= 0) {
            const float* vr = P + (size_t)(ch * 64) * DIN + 4096 + h * HD + lane;
            for (int src = 0; src < 64; ++src) o += __shfl(sc[s], src) * vr[(size_t)src * DIN];
        }
    }
    mixed[(size_t)t * DM + DCONV + h * HD + lane] = o / l;
}

__global__ void __launch_bounds__(256) k_gemm_out(const float* __restrict__ mixed, const float* __restrict__ w, const float* __restrict__ x, float* __restrict__ x1) {
    const int n0 = blockIdx.x * 64, m0 = blockIdx.y * 64;
    gemm64_f32(DM,
        [&](int m, int k) { return *(const float4*)&mixed[(size_t)(m0 + m) * DM + k]; },
        [&](int k, int n) { return *(const float4*)&w[(size_t)k * DM + n0 + n]; },
        [&](int m, int n, float4 v) {
            const size_t o = (size_t)(m0 + m) * DM + n0 + n; const float4 r = *(const float4*)&x[o];
            *(float4*)&x1[o] = make_float4(r.x + v.x, r.y + v.y, r.z + v.z, r.w + v.w); });
}

__global__ void __launch_bounds__(64) k_router(const float* __restrict__ x1, const float* __restrict__ g2, const float* __restrict__ wg, const float* __restrict__ bg,
                                               const float* __restrict__ we, const float* __restrict__ be, float* __restrict__ h2,
                                               int* __restrict__ cnt, int* __restrict__ ltk, float* __restrict__ lgt) {
    __shared__ float hs[DM];
    const int t = blockIdx.x, lane = threadIdx.x;
    const float* xr = x1 + (size_t)t * DM;
    float ss = 0.f;
    for (int i = 0; i < 32; ++i) { const float v = xr[lane + 64 * i]; ss += v * v; }
    ss = wave_sum(ss);
    const float rstd = rsqrtf(ss * (1.f / DM) + 1e-6f);
    for (int i = 0; i < 32; ++i) { const int k = lane + 64 * i; const float v = xr[k] * rstd * g2[k]; hs[k] = v; h2[(size_t)t * DM + k] = v; }
    __syncthreads();
    float ae = 0.f, ag = 0.f;
    for (int k = 0; k < DM; ++k) { const float hv = hs[k]; ae += hv * we[k * NE + lane]; ag += hv * wg[k * NG + (lane & 7)]; }
    const float el = ae + be[lane], gl = ag + bg[lane & 7];
    float gmax = -INFINITY; int grp = 0;
    for (int g = 0; g < NG; ++g) { const float v = __shfl(gl, g); if (v > gmax) { gmax = v; grp = g; } }
    float sum = 0.f;
    for (int g = 0; g < NG; ++g) sum += __expf(__shfl(gl, g) - gmax);
    const float pgrp = 1.f / sum;
    float v0 = -INFINITY, v1 = -INFINITY; int i0 = 0, i1 = 0;
    for (int i = 0; i < EPG; ++i) {
        const float v = __shfl(el, grp * EPG + i);
        if (v > v0) { v1 = v0; i1 = i0; v0 = v; i0 = i; } else if (v > v1) { v1 = v; i1 = i; }
    }
    const float e1 = __expf(v1 - v0), inv = 1.f / (1.f + e1);
    if (lane == 0) {
        const int ea = grp * EPG + i0, eb = grp * EPG + i1;
        const int sa = atomicAdd(&cnt[ea], 1); ltk[ea * LCAP + sa] = t * 2 + 0; lgt[ea * LCAP + sa] = inv * pgrp;
        const int sb = atomicAdd(&cnt[eb], 1); ltk[eb * LCAP + sb] = t * 2 + 1; lgt[eb * LCAP + sb] = e1 * inv * pgrp;
    }
}

__global__ void k_prefix(const int* __restrict__ cnt, int* __restrict__ off) {
    if (threadIdx.x == 0 && blockIdx.x == 0) { int a = 0; for (int e = 0; e < NE; ++e) { off[e] = a; a += cnt[e]; } off[NE] = a; }
}

__global__ void __launch_bounds__(256) k_moe_up(const float* __restrict__ h2, const float* __restrict__ wgate, const float* __restrict__ wup,
                                                const int* __restrict__ cnt, const int* __restrict__ off, const int* __restrict__ ltk, float* __restrict__ G) {
    const int e = blockIdx.z, mt = blockIdx.y, nt = blockIdx.x;
    const int ce = cnt[e];
    if (mt * 64 >= ce) return;
    const int am = threadIdx.x >> 2; const int idx = mt * 64 + am;
    const int tok = idx < ce ? (ltk[e * LCAP + idx] >> 1) : -1;
    const float* W = (nt < 8 ? wgate : wup) + (size_t)e * DM * DE + (nt & 7) * 64;
    const int ob = off[e];
    gemm64_f32(DM,
        [&](int m, int k) { return tok >= 0 ? *(const float4*)&h2[(size_t)tok * DM + k] : make_float4(0.f, 0.f, 0.f, 0.f); },
        [&](int k, int n) { return *(const float4*)&W[(size_t)k * DE + n]; },
        [&](int m, int n, float4 v) { const int id = mt * 64 + m; if (id < ce) *(float4*)&G[(size_t)(ob + id) * 1024 + nt * 64 + n] = v; });
}

__global__ void __launch_bounds__(256) k_moe_down(const float* __restrict__ G, const float* __restrict__ wdown, const int* __restrict__ cnt, const int* __restrict__ off,
                                                  const int* __restrict__ ltk, const float* __restrict__ lgt, float* __restrict__ Y) {
    const int e = blockIdx.z, mt = blockIdx.y, nt = blockIdx.x;
    const int ce = cnt[e];
    if (mt * 64 >= ce) return;
    const int am = threadIdx.x >> 2; const int idx = mt * 64 + am;
    const int ob = off[e];
    const float* W = wdown + (size_t)e * DE * DM + nt * 64;
    gemm64_f32(DE,
        [&](int m, int k) {
            if (idx >= ce) return make_float4(0.f, 0.f, 0.f, 0.f);
            const float4 g = *(const float4*)&G[(size_t)(ob + idx) * 1024 + k], u = *(const float4*)&G[(size_t)(ob + idx) * 1024 + 512 + k];
            return make_float4(g.x * sigmoidf_(g.x) * u.x, g.y * sigmoidf_(g.y) * u.y, g.z * sigmoidf_(g.z) * u.z, g.w * sigmoidf_(g.w) * u.w); },
        [&](int k, int n) { return *(const float4*)&W[(size_t)k * DM + n]; },
        [&](int m, int n, float4 v) {
            const int id = mt * 64 + m;
            if (id < ce) { const int tk = ltk[e * LCAP + id]; const float gt = lgt[e * LCAP + id];
                *(float4*)&Y[(size_t)tk * DM + nt * 64 + n] = make_float4(gt * v.x, gt * v.y, gt * v.z, gt * v.w); } });
}

__global__ void __launch_bounds__(256) k_final(const float* __restrict__ x1, const float* __restrict__ Y, const float* __restrict__ g, float* __restrict__ out) {
    const int row = blockIdx.x * 4 + (threadIdx.x >> 6), lane = threadIdx.x & 63;
    const float* xr = x1 + (size_t)row * DM; const float* y0 = Y + (size_t)(2 * row) * DM; const float* y1 = y0 + DM;
    float ss = 0.f;
    for (int i = 0; i < 32; ++i) { const int k = lane + 64 * i; const float v = xr[k] + y0[k] + y1[k]; ss += v * v; }
    ss = wave_sum(ss);
    const float rstd = rsqrtf(ss * (1.f / DM) + 1e-6f);
    for (int i = 0; i < 32; ++i) { const int k = lane + 64 * i; const float v = xr[k] + y0[k] + y1[k]; out[(size_t)row * DM + k] = v * rstd * g[k]; }
}

extern "C" void kernel_launch(void* const* d_in, const int* in_sizes, int n_in, void* d_out, int out_size, void* d_ws, size_t ws_size, hipStream_t stream) {
    const float* x = (const float*)d_in[0]; const float* norm1_g = (const float*)d_in[1]; const float* w_in = (const float*)d_in[2];
    const float* w_dw = (const float*)d_in[3]; const float* b_dw = (const float*)d_in[4]; const float* ln_g = (const float*)d_in[5];
    const float* ln_b = (const float*)d_in[6]; const float* rel_bias = (const float*)d_in[7]; const float* w_out = (const float*)d_in[8];
    const float* norm2_g = (const float*)d_in[9]; const float* w_group = (const float*)d_in[10]; const float* b_group = (const float*)d_in[11];
    const float* w_er = (const float*)d_in[12]; const float* b_er = (const float*)d_in[13]; const float* w_gate = (const float*)d_in[14];
    const float* w_up = (const float*)d_in[15]; const float* w_down = (const float*)d_in[16]; const float* final_g = (const float*)d_in[17];
    char* ws = (char*)d_ws;
    int* cnt = (int*)(ws + WS_CTL); int* off = cnt + 64;
    int* ltk = (int*)(ws + WS_LTK); float* lgt = (float*)(ws + WS_LGT);
    float* H = (float*)(ws + WS_H); float* P = (float*)(ws + WS_P); float* MIX = (float*)(ws + WS_MIX);
    float* X1 = (float*)(ws + WS_X1); float* G = (float*)(ws + WS_G); float* Y = (float*)(ws + WS_Y);
    float* out = (float*)d_out;
    hipMemsetAsync(ws + WS_CTL, 0, 4096, stream);
    k_rmsnorm<<<SEQ / 4, 256, 0, stream>>>(x, norm1_g, H);
    k_gemm_in<<<dim3(DIN / 64, SEQ / 64), 256, 0, stream>>>(H, w_in, P);
    k_conv<<<SEQ, 256, 0, stream>>>(P, w_dw, b_dw, ln_g, ln_b, MIX);
    k_attn<<<dim3(SEQ, NH / 4), 256, 0, stream>>>(P, rel_bias, MIX);
    k_gemm_out<<<dim3(DM / 64, SEQ / 64), 256, 0, stream>>>(MIX, w_out, x, X1);
    k_router<<<SEQ, 64, 0, stream>>>(X1, norm2_g, w_group, b_group, w_er, b_er, H, cnt, ltk, lgt);
    k_prefix<<<1, 64, 0, stream>>>(cnt, off);
    k_moe_up<<<dim3(16, LCAP / 64, NE), 256, 0, stream>>>(H, w_gate, w_up, cnt, off, ltk, G);
    k_moe_down<<<dim3(DM / 64, LCAP / 64, NE), 256, 0, stream>>>(G, w_down, cnt, off, ltk, lgt, Y);
    k_final<<<SEQ / 4, 256, 0, stream>>>(X1, Y, final_g, out);
}
```

```cpp
#include <hip/hip_runtime.h>
#include <stdint.h>
#include <cstdio>

#ifndef FAST_GEMM1
#define FAST_GEMM1 1
#endif
#ifndef FAST_ATTN
#define FAST_ATTN 0
#endif
#ifndef FAST_GEMM2
#define FAST_GEMM2 1
#endif
#ifndef FAST_ROUTER
#define FAST_ROUTER 0
#endif
#ifndef FAST_MOE
#define FAST_MOE 1
#endif

#define LAS __attribute__((address_space(3)))
#define GAS __attribute__((address_space(1)))
typedef unsigned short bf16_t;
typedef unsigned v4u __attribute__((ext_vector_type(4)));
typedef unsigned v2u __attribute__((ext_vector_type(2)));
typedef float f32x4 __attribute__((ext_vector_type(4)));
typedef float f32x16 __attribute__((ext_vector_type(16)));
typedef short bf16x8 __attribute__((ext_vector_type(8)));

constexpr int DM = 2048, SEQ = 8192, DCONV = 1024, DATT = 1024, HD = 64, NH = 16, DIN = 5120;
constexpr int CHUNK = 64, LEFT = 8, RCLIP = 128, NREL = 257, CW = 31;
constexpr int NG = 8, EPG = 8, NE = 64, DE = 512;
constexpr int LCAP = 8192;
constexpr int NWAVES = 8, NTHR = 512;
constexpr float LOG2E = 1.4426950408889634f;
constexpr float QSCALE = 0.125f * LOG2E;
constexpr int NRT = 80;

constexpr size_t MiB = 1ull << 20;
constexpr size_t WS_CTL = 0, CTL_BYTES = 1 * MiB;
constexpr size_t CTL_CNT = 524288;
constexpr size_t WS_LTK = 1 * MiB, WS_LGT = 3 * MiB, WS_RSTD2 = 5 * MiB, WS_SSP = 6 * MiB, WS_WRT = 7 * MiB;
constexpr size_t WS_WINT = 8 * MiB, WS_WOUTT = 28 * MiB, WS_HB = 36 * MiB, WS_U = 68 * MiB;
constexpr size_t WS_QH = 84 * MiB, WS_KH = 100 * MiB, WS_VH = 116 * MiB, WS_MIX = 132 * MiB;
constexpr size_t WS_X1 = 164 * MiB, WS_X1G = 228 * MiB, WS_HM = 260 * MiB, WS_Y = 280 * MiB;
constexpr size_t WS_WGT = 344 * MiB, WS_WUT = 472 * MiB, WS_WDT = 600 * MiB, WS_VG = 728 * MiB, WS_END = 792 * MiB;

struct Params {
    const float *x, *norm1_g, *w_in, *w_dw, *b_dw, *ln_g, *ln_b, *rel_bias, *w_out, *norm2_g, *w_group, *b_group, *w_er, *b_er, *w_gate, *w_up, *w_down, *final_g;
    float* out; unsigned char* ws;
    int ph_lo, ph_hi, li, pad;
};

typedef const __attribute__((address_space(4))) Params* CParams;
__device__ __forceinline__ CParams kparams() { CParams kp = (CParams)__builtin_amdgcn_kernarg_segment_ptr(); asm volatile("" : "+s"(kp)); return kp; }
__device__ __forceinline__ CParams relaunder(CParams kp) { asm volatile("" : "+s"(kp)); return kp; }

__device__ __forceinline__ float bf2f(unsigned b) { return __uint_as_float(b << 16); }
__device__ __forceinline__ unsigned f2bf(float f) { unsigned u = __float_as_uint(f); return (u + 0x7fffu + ((u >> 16) & 1u)) >> 16; }
__device__ __forceinline__ unsigned pk2(float lo, float hi) { return f2bf(lo) | (f2bf(hi) << 16); }
__device__ __forceinline__ float wave_sum(float v) {
#pragma unroll
    for (int o = 1; o < 64; o <<= 1) v += __shfl_xor(v, o);
    return v;
}
__device__ __forceinline__ float wave_max(float v) {
#pragma unroll
    for (int o = 1; o < 64; o <<= 1) v = fmaxf(v, __shfl_xor(v, o));
    return v;
}
__device__ __forceinline__ float sigmoidf_(float x) { return 1.f / (1.f + __expf(-x)); }
__host__ __device__ __forceinline__ int wint_row(int n) {
    if (n < 1024) return 256 * (n >> 7) + (n & 127);
    if (n < 2048) { const int m = n - 1024; return 256 * (m >> 7) + 128 + (m & 127); }
    return n;
}

__device__ __forceinline__ void p0_transpose_item(const float* W, int ldw, int k0, int n0, bf16_t* WT, int K, int orow0, LAS float* scr, int lane) {
#pragma unroll 8
    for (int i = 0; i < 32; ++i) { const int kk = 2 * i + (lane >> 5); scr[kk * 33 + (lane & 31)] = W[(size_t)(k0 + kk) * ldw + n0 + (lane & 31)]; }
    asm volatile("s_waitcnt lgkmcnt(0)" ::: "memory");
    const int c = lane & 7;
#pragma unroll
    for (int j = 0; j < 4; ++j) { const int n = (lane >> 3) + 8 * j; const LAS float* s = scr + (8 * c) * 33 + n;
        v4u o; o.x = pk2(s[0 * 33], s[1 * 33]); o.y = pk2(s[2 * 33], s[3 * 33]); o.z = pk2(s[4 * 33], s[5 * 33]); o.w = pk2(s[6 * 33], s[7 * 33]);
        *(v4u*)(WT + (size_t)(orow0 + n) * K + k0 + 8 * c) = o; }
    asm volatile("s_waitcnt lgkmcnt(0)" ::: "memory");
}

__device__ __forceinline__ void phase_prologue(CParams P, int vcu, int G, LAS unsigned char* lds) {
    const int tid = threadIdx.x, lane = tid & 63, wave = __builtin_amdgcn_readfirstlane(tid >> 6);
    LAS float* scr = (LAS float*)(lds + wave * 16384);
    const int gw = vcu * NWAVES + wave, NGW = G * NWAVES;
    bf16_t* WinT = (bf16_t*)(P->ws + WS_WINT); bf16_t* WoutT = (bf16_t*)(P->ws + WS_WOUTT); bf16_t* WrT = (bf16_t*)(P->ws + WS_WRT);
    bf16_t* Hb = (bf16_t*)(P->ws + WS_HB);
    bf16_t* WgT = (bf16_t*)(P->ws + WS_WGT); bf16_t* WuT = (bf16_t*)(P->ws + WS_WUT); bf16_t* WdT = (bf16_t*)(P->ws + WS_WDT);
    for (int m = gw; m < SEQ; m += NGW) {
        const f32x4* xr = (const f32x4*)(P->x + (size_t)m * DM) + lane; const f32x4* gr = (const f32x4*)P->norm1_g + lane;
        f32x4 v[8]; float s = 0.f;
#pragma unroll
        for (int j = 0; j < 8; ++j) { v[j] = xr[64 * j]; s += (v[j].x * v[j].x + v[j].y * v[j].y) + (v[j].z * v[j].z + v[j].w * v[j].w); }
        const float rstd = rsqrtf(wave_sum(s) * (1.f / DM) + 1e-6f);
        v2u* o8 = (v2u*)(Hb + (size_t)m * DM) + lane;
#pragma unroll
        for (int j = 0; j < 8; ++j) { const f32x4 g = gr[64 * j]; v2u o; o.x = pk2(v[j].x * rstd * g.x, v[j].y * rstd * g.y); o.y = pk2(v[j].z * rstd * g.z, v[j].w * rstd * g.w); o8[64 * j] = o; }
    }
    constexpr int I_IN = (DM / 64) * (DIN / 32), I_OUT = (DM / 64) * (DM / 32), I_GU = (DM / 64) * (DE / 32), I_DN = (DE / 64) * (DM / 32);
    constexpr int NITEMS = I_IN + I_OUT + NE * (2 * I_GU + I_DN);
    for (int it = gw; it < NITEMS; it += NGW) {
        int r = it;
        if (r < I_IN) { const int nb = r % (DIN / 32), kb = r / (DIN / 32); p0_transpose_item(P->w_in, DIN, 64 * kb, 32 * nb, WinT, DM, wint_row(32 * nb), scr, lane); continue; } r -= I_IN;
        if (r < I_OUT) { const int nb = r % (DM / 32), kb = r / (DM / 32); p0_transpose_item(P->w_out, DM, 64 * kb, 32 * nb, WoutT, DM, 32 * nb, scr, lane); continue; } r -= I_OUT;
        const int e = r / (2 * I_GU + I_DN); r -= e * (2 * I_GU + I_DN);
        if (r < I_GU) { const int nb = r % (DE / 32), kb = r / (DE / 32); p0_transpose_item(P->w_gate + (size_t)e * DM * DE, DE, 64 * kb, 32 * nb, WgT + (size_t)e * DE * DM, DM, 32 * nb, scr, lane); continue; } r -= I_GU;
        if (r < I_GU) { const int nb = r % (DE / 32), kb = r / (DE / 32); p0_transpose_item(P->w_up + (size_t)e * DM * DE, DE, 64 * kb, 32 * nb, WuT + (size_t)e * DE * DM, DM, 32 * nb, scr, lane); continue; } r -= I_GU;
        { const int nb = r % (DM / 32), kb = r / (DM / 32); p0_transpose_item(P->w_down + (size_t)e * DE * DM, DM, 64 * kb, 32 * nb, WdT + (size_t)e * DM * DE, DE, 32 * nb, scr, lane); }
    }
    for (int idx = (vcu * NTHR + tid); idx < NRT * DM; idx += G * NTHR) {
        const int n = idx / DM, k = idx % DM;
        float v = 0.f; if (n < NG) v = P->w_group[k * NG + n]; else if (n < NG + NE) v = P->w_er[k * NE + (n - NG)];
        WrT[idx] = (bf16_t)f2bf(v);
    }
}

constexpr int CONV_T = 16, CONV_ROWS = CONV_T + CW - 1;
constexpr int CONV_LDS_RED = 96 * 1024;
__device__ __forceinline__ void conv_item(CParams P, int item, LAS unsigned char* lds) {
    const int tid = threadIdx.x, lane = tid & 63, wave = tid >> 6;
    const bf16_t* U = (const bf16_t*)(P->ws + WS_U); bf16_t* MIX = (bf16_t*)(P->ws + WS_MIX);
    const int t0 = item * CONV_T;
    __syncthreads();
    for (int idx = tid; idx < CONV_ROWS * 128; idx += NTHR) {
        const int r = idx >> 7, ch = idx & 127, t = t0 - (CW - 1) + r;
        v4u v = {0u, 0u, 0u, 0u}; if (t >= 0) v = *(const v4u*)(U + (size_t)t * DCONV + ch * 8);
        *(LAS v4u*)(lds + r * 2048 + ch * 16) = v;
    }
    float w0[CW], w1[CW];
#pragma unroll
    for (int j = 0; j < CW; ++j) { const float2 w = *(const float2*)(P->w_dw + j * DCONV + 2 * tid); w0[j] = w.x; w1[j] = w.y; }
    const float2 bb = *(const float2*)(P->b_dw + 2 * tid);
    float a0[CONV_T], a1[CONV_T];
#pragma unroll
    for (int t = 0; t < CONV_T; ++t) { a0[t] = bb.x; a1[t] = bb.y; }
    __syncthreads();
#pragma unroll
    for (int r = 0; r < CONV_ROWS; ++r) {
        const unsigned u2 = *(const LAS unsigned*)(lds + r * 2048 + tid * 4);
        const float ua = bf2f(u2 & 0xffffu), ub = bf2f(u2 >> 16);
#pragma unroll
        for (int t = 0; t < CONV_T; ++t) { const int j = r - t; if (j >= 0 && j < CW) { a0[t] += w0[j] * ua; a1[t] += w1[j] * ub; } }
    }
    LAS float* red = (LAS float*)(lds + CONV_LDS_RED);
    LAS float* st = red + NWAVES * CONV_T * 2;
#pragma unroll
    for (int t = 0; t < CONV_T; ++t) {
        const float s = wave_sum(a0[t] + a1[t]), q = wave_sum(a0[t] * a0[t] + a1[t] * a1[t]);
        if (lane == 0) { red[(wave * CONV_T + t) * 2] = s; red[(wave * CONV_T + t) * 2 + 1] = q; }
    }
    __syncthreads();
    if (tid < CONV_T) {
        float s = 0.f, q = 0.f;
        for (int w = 0; w < NWAVES; ++w) { s += red[(w * CONV_T + tid) * 2]; q += red[(w * CONV_T + tid) * 2 + 1]; }
        const float mu = s * (1.f / DCONV), var = fmaxf(q * (1.f / DCONV) - mu * mu, 0.f);
        st[tid * 2] = mu; st[tid * 2 + 1] = rsqrtf(var + 1e-5f);
    }
    __syncthreads();
    const float2 lg = *(const float2*)(P->ln_g + 2 * tid), lb = *(const float2*)(P->ln_b + 2 * tid);
#pragma unroll
    for (int t = 0; t < CONV_T; ++t) {
        const float mu = st[t * 2], rs = st[t * 2 + 1];
        const float u0 = (a0[t] - mu) * rs * lg.x + lb.x, u1 = (a1[t] - mu) * rs * lg.y + lb.y;
        *(unsigned*)(MIX + (size_t)(t0 + t) * DM + 2 * tid) = pk2(u0 * sigmoidf_(u0), u1 * sigmoidf_(u1));
    }
}

__device__ __forceinline__ void phase_final(CParams P, int vcu, int G) {
    const int tid = threadIdx.x, lane = tid & 63, wave = tid >> 6;
    const float* X1 = (const float*)(P->ws + WS_X1); const bf16_t* Y = (const bf16_t*)(P->ws + WS_Y);
    for (int m = vcu * NWAVES + wave; m < SEQ; m += G * NWAVES) {
        const f32x4* xr = (const f32x4*)(X1 + (size_t)m * DM) + lane;
        const v2u* y0 = (const v2u*)(Y + (size_t)(2 * m) * DM) + lane; const v2u* y1 = (const v2u*)(Y + (size_t)(2 * m + 1) * DM) + lane;
        f32x4 v[8]; float s = 0.f;
#pragma unroll
        for (int j = 0; j < 8; ++j) {
            v[j] = xr[64 * j]; const v2u a = y0[64 * j], b = y1[64 * j];
            v[j].x += bf2f(a.x & 0xffffu) + bf2f(b.x & 0xffffu); v[j].y += bf2f(a.x >> 16) + bf2f(b.x >> 16);
            v[j].z += bf2f(a.y & 0xffffu) + bf2f(b.y & 0xffffu); v[j].w += bf2f(a.y >> 16) + bf2f(b.y >> 16);
            s += (v[j].x * v[j].x + v[j].y * v[j].y) + (v[j].z * v[j].z + v[j].w * v[j].w);
        }
        const float rstd = rsqrtf(wave_sum(s) * (1.f / DM) + 1e-6f);
        f32x4* o = (f32x4*)(P->out + (size_t)m * DM) + lane; const f32x4* g = (const f32x4*)P->final_g + lane;
#pragma unroll
        for (int j = 0; j < 8; ++j) o[64 * j] = v[j] * rstd * g[64 * j];
    }
}

namespace g8 {
constexpr int BM = 256, BK = 64, HALF = 128, HTB = HALF * BK * 2, STAGE_BYTES = 8 * HTB, NXCD = 8, WGM = 8;
__host__ __device__ __forceinline__ int lds_byte(int r, int c) { const int st = (r >> 4) * 2 + (c >> 5), rr = r & 15, cc = c & 31, ob = rr * 64 + cc * 2; return st * 1024 + (ob ^ (((ob >> 9) & 1) << 5)); }
__host__ __device__ __forceinline__ void stage_rc(int b, int& R, int& C) { const int st = b / 1024, sb = b % 1024, swz = sb ^ (((sb >> 9) & 1) << 5); R = (st >> 1) * 16 + swz / 64; C = (st & 1) * 32 + (swz % 64) / 2; }
__host__ __device__ __forceinline__ int perm32(int rho) { const int n = rho >> 4, i = rho & 15; return 8 * (i >> 2) + 4 * n + (i & 3); }
__device__ __forceinline__ unsigned cvt_pk_bf16(float lo, float hi) { unsigned r; asm volatile("v_cvt_pk_bf16_f32 %0, %1, %2" : "=v"(r) : "v"(lo), "v"(hi)); return r; }

struct Unit { const char* a; const char* b; int i0, i1, i2; };

template <class Epi, class Sched, bool GATHER>
__device__ __forceinline__ void gemm_phase(LAS unsigned char* lds, const int K, const size_t astep, const size_t bstep, const Sched& S, const Epi& E) {
    const int tid = threadIdx.x, wid = __builtin_amdgcn_readfirstlane(tid >> 6), lane = tid & 63, wr = wid >> 2, wc = wid & 3, fr = lane & 15, fq = lane >> 4;
    const int nt = K / BK;
    unsigned voffB[2], voffA0[2], voffA1[2];
#pragma unroll
    for (int i = 0; i < 2; ++i) { int R, C; stage_rc(tid * 16 + i * 8192, R, C); const int Rb = (R & ~31) + perm32(R & 31);
        voffB[i] = (unsigned)(Rb * K + C) * 2u; voffA0[i] = (unsigned)(R * K + C) * 2u; voffA1[i] = voffA0[i]; }
    const size_t kstep = (size_t)(BK * 2);
    const unsigned ldsw = (unsigned)wid * 1024u;
    const int aoff = lds_byte(wr * 64 + fr, fq * 8), boff = lds_byte(wc * 32 + fr, fq * 8);
#define G8_SA(b, h) (((b) * 2 + (h)) * HTB)
#define G8_SB(b, h) ((4 + (b) * 2 + (h)) * HTB)
#define G8_STAGE(bufoff, gbase, voff) do { _Pragma("unroll") for (int _i = 0; _i < 2; ++_i) \
        __builtin_amdgcn_global_load_lds((const unsigned*)((const char*)(gbase) + (voff)[_i]), (LAS unsigned*)(lds + (bufoff) + ldsw + _i * 8192), 16, 0, 0); } while (0)
#define G8_LDA(dst, b, h) do { _Pragma("unroll") for (int m = 0; m < 4; ++m) _Pragma("unroll") for (int k = 0; k < 2; ++k) dst[m][k] = *(const LAS bf16x8*)(lds + G8_SA(b, h) + aoff + m * 2048 + k * 1024); } while (0)
#define G8_LDB(dst, b, h) do { _Pragma("unroll") for (int n = 0; n < 2; ++n) _Pragma("unroll") for (int k = 0; k < 2; ++k) dst[n][k] = *(const LAS bf16x8*)(lds + G8_SB(b, h) + boff + n * 2048 + k * 1024); } while (0)
#define G8_MMA(ai, bj, At, Bt) do { __builtin_amdgcn_s_setprio(1); _Pragma("unroll") for (int m = 0; m < 4; ++m) _Pragma("unroll") for (int n = 0; n < 2; ++n) _Pragma("unroll") for (int k = 0; k < 2; ++k) \
        acc[ai][bj][m][n] = __builtin_amdgcn_mfma_f32_16x16x32_bf16(Bt[n][k], At[m][k], acc[ai][bj][m][n], 0, 0, 0); __builtin_amdgcn_s_setprio(0); } while (0)
#define G8_WAIT_V(n) asm volatile("s_waitcnt vmcnt(" #n ")" ::: "memory")
#define G8_WAIT_L(n) asm volatile("s_waitcnt lgkmcnt(" #n ")" ::: "memory")
#define G8_BAR __builtin_amdgcn_s_barrier()
#define G8_SCHED __builtin_amdgcn_sched_barrier(0)
#define G8_GOFF(u) do { if (GATHER) { _Pragma("unroll") for (int _i = 0; _i < 2; ++_i) { int R_, C_; stage_rc(tid * 16 + _i * 8192, R_, C_); \
        voffA0[_i] = S.row_off(u, R_) + (unsigned)C_ * 2u; voffA1[_i] = S.row_off(u, R_ + HALF) + (unsigned)C_ * 2u; } } } while (0)
    Unit cur, nxt; int ui = 0;
    if (!S.next(0, cur)) return;
    f32x4 acc[2][2][4][2];
#pragma unroll
    for (int a = 0; a < 2; ++a)
#pragma unroll
        for (int b = 0; b < 2; ++b)
#pragma unroll
            for (int m = 0; m < 4; ++m)
#pragma unroll
                for (int n = 0; n < 2; ++n) acc[a][b][m][n] = (f32x4){0.f, 0.f, 0.f, 0.f};
    bf16x8 At[4][2], B0[2][2], B1[2][2];
    const char* cA0 = cur.a; const char* cB0 = cur.b;
#define cA1 (cA0 + astep)
#define cB1 (cB0 + bstep)
    G8_GOFF(cur);
    G8_STAGE(G8_SB(0, 0), cB0, voffB); G8_STAGE(G8_SB(0, 1), cB1, voffB); G8_STAGE(G8_SA(0, 0), cA0, voffA0); G8_STAGE(G8_SA(0, 1), cA1, voffA1);
    if (wr == 1) G8_BAR;
    G8_WAIT_V(2); G8_BAR;
    G8_STAGE(G8_SB(1, 0), cB0 + kstep, voffB); G8_STAGE(G8_SA(1, 0), cA0 + kstep, voffA0); G8_STAGE(G8_SB(1, 1), cB1 + kstep, voffB);
    G8_WAIT_V(6); G8_BAR;
    for (;;) {
        const bool has_next = S.next(ui + 1, nxt);
        const char* nA0 = has_next ? nxt.a : cA0; const char* nB0 = has_next ? nxt.b : cB0;
        for (int t = 0; t < nt; t += 2) {
            const bool last = (t == nt - 2);
            const char* a1h = cA1 + (size_t)(t + 1) * kstep;
            const char* a2_0 = last ? nA0 : cA0 + (size_t)(t + 2) * kstep; const char* a2_1 = a2_0 + astep;
            const char* b2_0 = last ? nB0 : cB0 + (size_t)(t + 2) * kstep; const char* b2_1 = b2_0 + bstep;
            const char* a3_0 = a2_0 + kstep; const char* b3_0 = b2_0 + kstep; const char* b3_1 = b2_1 + kstep;
            G8_LDB(B0, 0, 0); G8_LDB(B1, 0, 1); G8_SCHED; G8_LDA(At, 0, 0); G8_STAGE(G8_SA(1, 1), a1h, voffA1);
            G8_WAIT_V(8); G8_WAIT_L(0); G8_BAR; G8_MMA(0, 0, At, B0); G8_MMA(0, 1, At, B1); G8_BAR; G8_SCHED;
            if (GATHER) { if (last && has_next) { G8_GOFF(nxt); } }
            G8_LDA(At, 0, 1); G8_STAGE(G8_SB(0, 0), b2_0, voffB); G8_STAGE(G8_SB(0, 1), b2_1, voffB); G8_STAGE(G8_SA(0, 0), a2_0, voffA0);
            G8_WAIT_V(8); G8_WAIT_L(0); G8_BAR; G8_MMA(1, 0, At, B0); G8_MMA(1, 1, At, B1); G8_BAR; G8_SCHED;
            G8_LDB(B0, 1, 0); G8_LDB(B1, 1, 1); G8_SCHED; G8_LDA(At, 1, 0); G8_STAGE(G8_SA(0, 1), a2_1, voffA1);
            G8_WAIT_V(8); G8_WAIT_L(0); G8_BAR; G8_MMA(0, 0, At, B0); G8_MMA(0, 1, At, B1); G8_BAR; G8_SCHED;
            G8_LDA(At, 1, 1); G8_STAGE(G8_SB(1, 0), b3_0, voffB); G8_STAGE(G8_SB(1, 1), b3_1, voffB); G8_STAGE(G8_SA(1, 0), a3_0, voffA0);
            G8_WAIT_V(8); G8_WAIT_L(0); G8_BAR; G8_MMA(1, 0, At, B0); G8_MMA(1, 1, At, B1); G8_BAR; G8_SCHED;
        }
        if (wr == 0) G8_BAR;
        E(acc, cur, wr, wc, fr, fq);
        if (!has_next) break;
#pragma unroll
        for (int a = 0; a < 2; ++a)
#pragma unroll
            for (int b = 0; b < 2; ++b)
#pragma unroll
                for (int m = 0; m < 4; ++m)
#pragma unroll
                    for (int n = 0; n < 2; ++n) acc[a][b][m][n] = (f32x4){0.f, 0.f, 0.f, 0.f};
        cur = nxt; cA0 = nA0; cB0 = nB0; ++ui;
        if (wr == 1) G8_BAR;
    }
    G8_WAIT_V(0);
    G8_BAR;
#undef G8_SA
#undef G8_SB
#undef G8_STAGE
#undef G8_LDA
#undef G8_LDB
#undef G8_MMA
#undef G8_WAIT_V
#undef G8_WAIT_L
#undef G8_BAR
#undef G8_SCHED
#undef G8_GOFF
#undef cA1
#undef cB1
}

struct DenseOrder {
    int nM, nN, nwg, G, c, K; const char* A; const char* Bt;
    __device__ __forceinline__ void init(const void* A_, const void* Bt_, int M, int N, int K_, int G_, int c_) { A = (const char*)A_; Bt = (const char*)Bt_; nM = M / BM; nN = N / BM; nwg = nM * nN; G = G_; c = c_; K = K_; }
    __device__ __forceinline__ bool next(int i, Unit& u) const {
        const long L = (long)i * G + c; if (L >= nwg) return false;
        int wgid = (int)L; { const int q = nwg / NXCD, r = nwg % NXCD, xcd = wgid % NXCD, off = wgid / NXCD; wgid = (xcd < r ? xcd * (q + 1) : r * (q + 1) + (xcd - r) * q) + off; }
        const int nig = WGM * nN, gid = wgid / nig, fm = gid * WGM, gsz = (nM - fm) < WGM ? (nM - fm) : WGM;
        const int pm = fm + ((wgid % nig) % gsz), pn = (wgid % nig) / gsz;
        const size_t hstep = (size_t)HALF * K * 2;
        u.a = A + (size_t)pm * 2 * hstep; u.b = Bt + (size_t)pn * 2 * hstep; u.i0 = pm; u.i1 = pn; u.i2 = 0; return true;
    }
    __device__ __forceinline__ unsigned row_off(const Unit&, int) const { return 0u; }
};

struct EpiIn {
    CParams P;
    __device__ __forceinline__ void operator()(const f32x4 (&acc)[2][2][4][2], const Unit& u, int wr, int wc, int fr, int fq) const {
        unsigned char* ws = relaunder(P)->ws;
        bf16_t* U = (bf16_t*)(ws + WS_U); bf16_t* QKV = (bf16_t*)(ws + WS_QH);
        const int pm = u.i0, pn = u.i1;
        const int row0 = pm * BM + wr * 64 + fr;
        if (pn < 8) {
            bf16_t* base = U + (size_t)row0 * DCONV + pn * 128 + wc * 32 + 8 * fq;
#pragma unroll
            for (int ai = 0; ai < 2; ++ai)
#pragma unroll
                for (int m = 0; m < 4; ++m) {
                    float r[8];
#pragma unroll
                    for (int n = 0; n < 2; ++n)
#pragma unroll
                        for (int i = 0; i < 4; ++i) { const float v = acc[ai][0][m][n][i], g = acc[ai][1][m][n][i]; r[4 * n + i] = v * __builtin_amdgcn_rcpf(1.f + __expf(-g)); }
                    v4u w; w.x = cvt_pk_bf16(r[0], r[1]); w.y = cvt_pk_bf16(r[2], r[3]); w.z = cvt_pk_bf16(r[4], r[5]); w.w = cvt_pk_bf16(r[6], r[7]);
                    *(v4u*)(base + (size_t)(ai * HALF + m * 16) * DCONV) = w;
                }
        } else {
            const int which = (pn - 8) >> 2, hq = 4 * ((pn - 8) & 3) + (wc >> 1);
            const float sc = which == 0 ? QSCALE : 1.f;
            bf16_t* base = QKV + (size_t)which * ((size_t)NH * SEQ * HD) + (size_t)row0 * HD + (wc & 1) * 32 + 8 * fq;
#pragma unroll
            for (int ai = 0; ai < 2; ++ai)
#pragma unroll
                for (int m = 0; m < 4; ++m)
#pragma unroll
                    for (int bj = 0; bj < 2; ++bj) {
                        const f32x4 v0 = acc[ai][bj][m][0] * sc, v1 = acc[ai][bj][m][1] * sc;
                        v4u w; w.x = cvt_pk_bf16(v0[0], v0[1]); w.y = cvt_pk_bf16(v0[2], v0[3]); w.z = cvt_pk_bf16(v1[0], v1[1]); w.w = cvt_pk_bf16(v1[2], v1[3]);
                        *(v4u*)(base + ((size_t)(hq + 2 * bj) * SEQ + ai * HALF + m * 16) * HD) = w;
                    }
        }
    }
};
struct EpiOut {
    CParams P;
    __device__ __forceinline__ void operator()(const f32x4 (&acc)[2][2][4][2], const Unit& u, int wr, int wc, int fr, int fq) const {
        CParams Q = relaunder(P);
        const float* x = Q->x; const float* g2 = Q->norm2_g; unsigned char* ws = Q->ws;
        float* X1 = (float*)(ws + WS_X1); bf16_t* X1G = (bf16_t*)(ws + WS_X1G); float* SSP = (float*)(ws + WS_SSP);
        const int pm = u.i0, pn = u.i1;
        const int row0 = pm * BM + wr * 64 + fr, col0 = pn * BM + wc * 32 + 8 * fq;
        f32x4 gv[2][2];
#pragma unroll
        for (int bj = 0; bj < 2; ++bj)
#pragma unroll
            for (int n = 0; n < 2; ++n) gv[bj][n] = *(const f32x4*)(g2 + col0 + bj * HALF + 4 * n);
#pragma unroll
        for (int ai = 0; ai < 2; ++ai)
#pragma unroll
            for (int m = 0; m < 4; ++m) {
                const int row = row0 + ai * HALF + m * 16; const size_t off = (size_t)row * DM + col0;
                float q = 0.f;
#pragma unroll
                for (int bj = 0; bj < 2; ++bj) {
                    const f32x4 s0 = *(const f32x4*)(x + off + bj * HALF) + acc[ai][bj][m][0], s1 = *(const f32x4*)(x + off + bj * HALF + 4) + acc[ai][bj][m][1];
                    *(f32x4*)(X1 + off + bj * HALF) = s0; *(f32x4*)(X1 + off + bj * HALF + 4) = s1;
                    q += (s0[0] * s0[0] + s0[1] * s0[1]) + (s0[2] * s0[2] + s0[3] * s0[3]) + (s1[0] * s1[0] + s1[1] * s1[1]) + (s1[2] * s1[2] + s1[3] * s1[3]);
                    const f32x4 t0 = s0 * gv[bj][0], t1 = s1 * gv[bj][1];
                    v4u w; w.x = cvt_pk_bf16(t0[0], t0[1]); w.y = cvt_pk_bf16(t0[2], t0[3]); w.z = cvt_pk_bf16(t1[0], t1[1]); w.w = cvt_pk_bf16(t1[2], t1[3]);
                    *(v4u*)(X1G + off + bj * HALF) = w;
                }
                q += __shfl_xor(q, 16); q += __shfl_xor(q, 32);
                if (fq == 0) SSP[(size_t)(pn * 4 + wc) * SEQ + row] = q;
            }
    }
};
constexpr int TAB_TS = 0, TAB_OS = 65, TAB_CN = 130;
template <int NT, bool DOWN>
struct MoeOrder {
    const LAS int* tab; int G, c; const char* wsb;
    __device__ __forceinline__ bool next(int i, Unit& u) const {
        const int L = i * G + c; const int T = L / NT, nt = L % NT;
        if (T >= tab[TAB_TS + NE]) return false;
        int e = 0;
        for (int j = 1; j < NE; ++j) e += (tab[TAB_TS + j] <= T) ? 1 : 0;
        e = __builtin_amdgcn_readfirstlane(e);
        const int mt = __builtin_amdgcn_readfirstlane(T - tab[TAB_TS + e]);
        const char* Abase = wsb + (DOWN ? WS_HM : WS_X1G); const char* Bbase = wsb + (DOWN ? WS_WDT : WS_WGT);
        if (DOWN) {
            const int ob = __builtin_amdgcn_readfirstlane(tab[TAB_OS + e]);
            u.a = Abase + (size_t)(ob + mt * BM) * (DE * 2);
            u.b = Bbase + (size_t)e * ((size_t)DM * DE * 2) + (size_t)nt * ((size_t)BM * DE * 2);
        } else {
            u.a = Abase;
            u.b = Bbase + (size_t)e * ((size_t)DE * DM * 2) + (size_t)nt * ((size_t)HALF * DM * 2);
        }
        u.i0 = e; u.i1 = mt; u.i2 = nt; return true;
    }
    __device__ __forceinline__ unsigned row_off(const Unit& u, int r) const {
        const int ce = tab[TAB_CN + u.i0]; int idx = u.i1 * BM + r; idx = idx < ce ? idx : ce - 1;
        return (unsigned)(((const int*)(wsb + WS_LTK))[u.i0 * LCAP + idx] >> 1) * (unsigned)(DM * 2);
    }
};
struct EpiUp {
    const LAS int* tab; CParams P;
    __device__ __forceinline__ void operator()(const f32x4 (&acc)[2][2][4][2], const Unit& u, int wr, int wc, int fr, int fq) const {
        unsigned char* ws = relaunder(P)->ws;
        const int* ltk = (const int*)(ws + WS_LTK); const float* rstd2 = (const float*)(ws + WS_RSTD2); bf16_t* HM = (bf16_t*)(ws + WS_HM);
        const int e = u.i0, mt = u.i1, nt = u.i2; const int ce = tab[TAB_CN + e], ob = tab[TAB_OS + e];
#pragma unroll
        for (int ai = 0; ai < 2; ++ai)
#pragma unroll
            for (int m = 0; m < 4; ++m) {
                const int idx = mt * BM + ai * HALF + wr * 64 + m * 16 + fr;
                if (idx < ce) {
                    const float rs = rstd2[ltk[e * LCAP + idx] >> 1];
                    float h[8];
#pragma unroll
                    for (int n = 0; n < 2; ++n)
#pragma unroll
                        for (int i = 0; i < 4; ++i) { const float g = acc[ai][0][m][n][i] * rs, uu = acc[ai][1][m][n][i] * rs; h[4 * n + i] = g * __builtin_amdgcn_rcpf(1.f + __expf(-g)) * uu; }
                    v4u w; w.x = cvt_pk_bf16(h[0], h[1]); w.y = cvt_pk_bf16(h[2], h[3]); w.z = cvt_pk_bf16(h[4], h[5]); w.w = cvt_pk_bf16(h[6], h[7]);
                    *(v4u*)(HM + (size_t)(ob + idx) * DE + nt * HALF + wc * 32 + 8 * fq) = w;
                }
            }
    }
};
struct EpiDown {
    const LAS int* tab; CParams P;
    __device__ __forceinline__ void operator()(const f32x4 (&acc)[2][2][4][2], const Unit& u, int wr, int wc, int fr, int fq) const {
        unsigned char* ws = relaunder(P)->ws;
        const int* ltk = (const int*)(ws + WS_LTK); const float* lgt = (const float*)(ws + WS_LGT); bf16_t* Y = (bf16_t*)(ws + WS_Y);
        const int e = u.i0, mt = u.i1, nt = u.i2; const int ce = tab[TAB_CN + e];
#pragma unroll
        for (int ai = 0; ai < 2; ++ai)
#pragma unroll
            for (int m = 0; m < 4; ++m) {
                const int idx = mt * BM + ai * HALF + wr * 64 + m * 16 + fr;
                if (idx < ce) {
                    const int tk = ltk[e * LCAP + idx]; const float gt = lgt[e * LCAP + idx];
                    bf16_t* rowp = Y + (size_t)tk * DM + nt * BM + wc * 32 + 8 * fq;
#pragma unroll
                    for (int bj = 0; bj < 2; ++bj) {
                        const f32x4 v0 = acc[ai][bj][m][0] * gt, v1 = acc[ai][bj][m][1] * gt;
                        v4u w; w.x = cvt_pk_bf16(v0[0], v0[1]); w.y = cvt_pk_bf16(v0[2], v0[3]); w.z = cvt_pk_bf16(v1[0], v1[1]); w.w = cvt_pk_bf16(v1[2], v1[3]);
                        *(v4u*)(rowp + bj * HALF) = w;
                    }
                }
            }
    }
};
}


#define XB_TMO      128
#define XB_XCNT(j)  (256  + 64 * (j))
#define XB_XSUB(j)  (1280 + 64 * (j))
#define XB_XGEN(j)  (2304 + 64 * (j))
#define XB_TOP      3328
#define XB_TOPGEN   3392
#define XCD_BAR_WORDS 3456
#define XB_SPIN_CAP (1u << 18)
__device__ __forceinline__ unsigned xb_ld(unsigned* p)              { return __hip_atomic_load(p, __ATOMIC_RELAXED, __HIP_MEMORY_SCOPE_AGENT); }
__device__ __forceinline__ unsigned xb_add(unsigned* p, unsigned v) { return __hip_atomic_fetch_add(p, v, __ATOMIC_RELAXED, __HIP_MEMORY_SCOPE_AGENT); }
__device__ __forceinline__ unsigned xb_xcc_id() { return (unsigned)__builtin_amdgcn_s_getreg((3 << 11) | 20) & 0xFu; }
#define XB_SPIN(cond, bar) do { unsigned _sp = 0; while (cond) { __builtin_amdgcn_s_sleep(1); \
    if ((++_sp & 255u) == 0u) { if (xb_ld(&(bar)[XB_TMO])) break; if (_sp > XB_SPIN_CAP) { atomicAdd(&(bar)[XB_TMO], 1u); break; } } } } while (0)
struct XcdBarrier { unsigned* bar; unsigned x; volatile LAS unsigned* st; };
__device__ __forceinline__ XcdBarrier xcd_barrier_post(unsigned* bar, volatile LAS unsigned* st) {
    XcdBarrier b; b.bar = bar; b.x = xb_xcc_id(); b.st = st;
    if (threadIdx.x == 0) (void)xb_add(&bar[XB_XCNT(b.x)], 1u);
    return b;
}
__device__ __forceinline__ void xcd_barrier_complete(unsigned* bar, unsigned x, unsigned& nloc, unsigned& nx) {
    const unsigned G = gridDim.x * gridDim.y * gridDim.z;
    unsigned sum, cnt, mine, sp = 0u;
    for (;;) {
        sum = 0u; cnt = 0u; mine = 0u;
#pragma unroll
        for (unsigned j = 0; j < 16; ++j) { const unsigned c = xb_ld(&bar[XB_XCNT(j)]); sum += c; cnt += (c > 0u) ? 1u : 0u; mine = (j == x) ? c : mine; }
        if (sum == G) break;
        __builtin_amdgcn_s_sleep(1);
        if ((++sp & 255u) == 0u) { if (xb_ld(&bar[XB_TMO])) break; if (sp > XB_SPIN_CAP) { atomicAdd(&bar[XB_TMO], 1u); break; } }
    }
    nloc = mine > 0u ? mine : 1u; nx = cnt > 0u ? cnt : 1u;
}
__device__ __forceinline__ void xcd_barrier(const XcdBarrier& b) {
    asm volatile("s_waitcnt vmcnt(0)" ::: "memory");
    __syncthreads();
    if (threadIdx.x == 0) {
        unsigned* bar = b.bar;
        __builtin_amdgcn_s_waitcnt(0);
        unsigned nloc = b.st[0], nx = b.st[1];
        if (nloc == 0u) { xcd_barrier_complete(bar, b.x, nloc, nx); b.st[0] = nloc; b.st[1] = nx; }
        const unsigned old = xb_add(&bar[XB_XSUB(b.x)], 1u);
        const unsigned gen = old / nloc;
        if (old + 1u == (gen + 1u) * nloc) {
            __builtin_amdgcn_fence(__ATOMIC_RELEASE, "agent");
            asm volatile("s_waitcnt vmcnt(0)" ::: "memory");
            const unsigned og = xb_add(&bar[XB_TOP], 1u);
            const unsigned tg = og / nx;
            if (og + 1u == (tg + 1u) * nx) xb_add(&bar[XB_TOPGEN], 1u);
            else XB_SPIN(xb_ld(&bar[XB_TOPGEN]) == tg, bar);
            __builtin_amdgcn_fence(__ATOMIC_ACQUIRE, "agent");
            xb_add(&bar[XB_XGEN(b.x)], 1u);
            asm volatile("s_waitcnt vmcnt(0)" ::: "memory");
        } else {
            XB_SPIN(xb_ld(&bar[XB_XGEN(b.x)]) == gen, bar);
            __builtin_amdgcn_fence(__ATOMIC_ACQUIRE, "agent");
            asm volatile("s_waitcnt vmcnt(0)" ::: "memory");
        }
    }
    __syncthreads();
}

__device__ __forceinline__ void attn_simple(CParams P, int vcu, int G) {
    unsigned char* ws = P->ws; const float* relb = P->rel_bias;
    const bf16_t* Qh = (const bf16_t*)(ws + WS_QH); const bf16_t* Kh = (const bf16_t*)(ws + WS_KH); const bf16_t* Vh = (const bf16_t*)(ws + WS_VH);
    bf16_t* MIX = (bf16_t*)(ws + WS_MIX);
    const int lane = threadIdx.x & 63, wave = threadIdx.x >> 6;
    for (int task = vcu * NWAVES + wave; task < SEQ * NH; task += G * NWAVES) {
        const int t = task >> 4, h = task & 15;
        const int c = t >> 6, i = t & 63;
        const float qd = bf2f(Qh[((size_t)h * SEQ + t) * HD + lane]);
        float sc[9];
#pragma unroll
        for (int s = 0; s < 9; ++s) {
            const int ch = c - LEFT + s;
            float v = -1e30f;
            if (ch >= 0) {
                const int kpos = ch * 64 + lane;
                const bf16_t* kr = Kh + ((size_t)h * SEQ + kpos) * HD;
                float acc = 0.f;
                for (int d = 0; d < HD; d += 4) {
                    const v2u kv = *(const v2u*)(kr + d);
                    acc += __shfl(qd, d) * bf2f(kv.x & 0xffffu) + __shfl(qd, d + 1) * bf2f(kv.x >> 16) + __shfl(qd, d + 2) * bf2f(kv.y & 0xffffu) + __shfl(qd, d + 3) * bf2f(kv.y >> 16);
                }
                const int j = s * 64 + lane;
                int rel = LEFT * CHUNK + i - j; rel = rel < -RCLIP ? -RCLIP : (rel > RCLIP ? RCLIP : rel);
                v = acc + relb[h * NREL + rel + RCLIP] * LOG2E;
            }
            sc[s] = v;
        }
        float m = sc[0];
#pragma unroll
        for (int s = 1; s < 9; ++s) m = fmaxf(m, sc[s]);
        m = wave_max(m);
        float l = 0.f;
#pragma unroll
        for (int s = 0; s < 9; ++s) { const int ch = c - LEFT + s; sc[s] = (ch >= 0) ? exp2f(sc[s] - m) : 0.f; l += sc[s]; }
        l = wave_sum(l);
        float o = 0.f;
#pragma unroll
        for (int s = 0; s < 9; ++s) {
            const int ch = c - LEFT + s;
            if (ch >= 0) {
                const bf16_t* vr = Vh + ((size_t)h * SEQ + ch * 64) * HD + lane;
                for (int src = 0; src < 64; ++src) o += __shfl(sc[s], src) * bf2f(vr[(size_t)src * HD]);
            }
        }
        MIX[(size_t)t * DM + DCONV + h * HD + lane] = (bf16_t)f2bf(o / l);
    }
}
__device__ __forceinline__ void router_simple(CParams P, int vcu, int G, LAS unsigned char* lds) {
    unsigned char* ws = P->ws; const float* bg = P->b_group; const float* be = P->b_er;
    const bf16_t* X1G = (const bf16_t*)(ws + WS_X1G); const float* SSP = (const float*)(ws + WS_SSP); const bf16_t* WrT = (const bf16_t*)(ws + WS_WRT);
    float* RSTD2 = (float*)(ws + WS_RSTD2); int* cnt = (int*)(ws + WS_CTL + CTL_CNT); int* ltk = (int*)(ws + WS_LTK); float* lgt = (float*)(ws + WS_LGT);
    const int lane = threadIdx.x & 63, wave = threadIdx.x >> 6;
    LAS float* hs = (LAS float*)(lds + wave * 8192);
    __syncthreads();
    for (int t = vcu * NWAVES + wave; t < SEQ; t += G * NWAVES) {
        float ss = 0.f;
        for (int i = 0; i < 32; ++i) ss += SSP[(size_t)i * SEQ + t];
        const float rstd = rsqrtf(ss * (1.f / DM) + 1e-6f);
        if (lane == 0) RSTD2[t] = rstd;
        asm volatile("s_waitcnt lgkmcnt(0)" ::: "memory");
        for (int i = 0; i < 32; ++i) { const int k = lane + 64 * i; hs[k] = bf2f(X1G[(size_t)t * DM + k]); }
        asm volatile("s_waitcnt lgkmcnt(0)" ::: "memory");
        float ae = 0.f, ag = 0.f;
        for (int k = 0; k < DM; ++k) { const float hv = hs[k]; ae += hv * bf2f(WrT[(size_t)(NG + lane) * DM + k]); ag += hv * bf2f(WrT[(size_t)(lane & 7) * DM + k]); }
        const float el = ae * rstd + be[lane], gl = ag * rstd + bg[lane & 7];
        float gmax = -INFINITY; int grp = 0;
        for (int g = 0; g < NG; ++g) { const float v = __shfl(gl, g); if (v > gmax) { gmax = v; grp = g; } }
        float sum = 0.f;
        for (int g = 0; g < NG; ++g) sum += __expf(__shfl(gl, g) - gmax);
        const float pgrp = 1.f / sum;
        float v0 = -INFINITY, v1 = -INFINITY; int i0 = 0, i1 = 0;
        for (int i = 0; i < EPG; ++i) {
            const float v = __shfl(el, grp * EPG + i);
            if (v > v0) { v1 = v0; i1 = i0; v0 = v; i0 = i; } else if (v > v1) { v1 = v; i1 = i; }
        }
        const float e1 = __expf(v1 - v0), inv = 1.f / (1.f + e1);
        if (lane == 0) {
            const int ea = grp * EPG + i0, eb = grp * EPG + i1;
            const int sa = atomicAdd(&cnt[ea], 1); ltk[ea * LCAP + sa] = t * 2 + 0; lgt[ea * LCAP + sa] = inv * pgrp;
            const int sb = atomicAdd(&cnt[eb], 1); ltk[eb * LCAP + sb] = t * 2 + 1; lgt[eb * LCAP + sb] = e1 * inv * pgrp;
        }
    }
}

constexpr int LDS_TAB = 131072;
constexpr int LDS_MISC = 131072 + 4096;
__device__ __forceinline__ void moe_build_table(CParams P, LAS unsigned char* lds) {
    LAS int* tab = (LAS int*)(lds + LDS_TAB);
    __syncthreads();
    if (threadIdx.x == 0) {
        int* cnt = (int*)(P->ws + WS_CTL + CTL_CNT);
        int ts = 0, os = 0;
        for (int e = 0; e < NE; ++e) { const int c = __hip_atomic_load(cnt + e, __ATOMIC_RELAXED, __HIP_MEMORY_SCOPE_AGENT); tab[g8::TAB_TS + e] = ts; tab[g8::TAB_OS + e] = os; tab[g8::TAB_CN + e] = c; ts += (c + 255) >> 8; os += c; }
        tab[g8::TAB_TS + NE] = ts; tab[g8::TAB_OS + NE] = os;
    }
    __syncthreads();
}
constexpr int LDS_BYTES = 147456;
__global__ void __launch_bounds__(NTHR, 2) mega(Params p_kernarg) {
    extern __shared__ __attribute__((aligned(16))) unsigned char lds_raw[];
    LAS unsigned char* lds = (LAS unsigned char*)lds_raw;
    const int G = gridDim.x, bx = blockIdx.x;
    const int vcu = (G % 8 == 0) ? (bx % 8) * (G / 8) + bx / 8 : bx;
    CParams P = kparams();
    const int lo = P->ph_lo, hi = P->ph_hi;
#define IN(k) (lo <= (k) && (k) < hi)
#define BOTH(k) (IN(k) && IN((k) + 1))
    volatile LAS unsigned* misc = (volatile LAS unsigned*)(lds + LDS_MISC);
    if (threadIdx.x < 32) misc[threadIdx.x] = 0u;
    __syncthreads();
    XcdBarrier bar; bar.bar = (unsigned*)(P->ws + WS_CTL) + P->li * XCD_BAR_WORDS; bar.x = 0; bar.st = misc + 8;
    if (hi - lo > 1) bar = xcd_barrier_post(bar.bar, misc + 8);
#define GRID_BAR(k) do { if (BOTH(k)) xcd_barrier(bar); } while (0)
    if (IN(0)) { phase_prologue(kparams(), vcu, G, lds); GRID_BAR(0); }
#if FAST_GEMM1
    if (IN(1)) {
        g8::DenseOrder S; S.init(P->ws + WS_HB, P->ws + WS_WINT, SEQ, DIN, DM, G, bx);
        g8::EpiIn E{P};
        g8::gemm_phase<g8::EpiIn, g8::DenseOrder, false>(lds, DM, (size_t)g8::HALF * DM * 2, (size_t)g8::HALF * DM * 2, S, E);
        GRID_BAR(1);
    }
#endif
    if (IN(2)) {
#if !FAST_ATTN
        attn_simple(kparams(), vcu, G);
#endif
        for (int it = vcu; it < SEQ / CONV_T; it += G) conv_item(kparams(), it, lds);
        GRID_BAR(2);
    }
#if FAST_GEMM2
    if (IN(3)) {
        g8::DenseOrder S; S.init(P->ws + WS_MIX, P->ws + WS_WOUTT, SEQ, DM, DM, G, bx);
        g8::EpiOut E{P};
        g8::gemm_phase<g8::EpiOut, g8::DenseOrder, false>(lds, DM, (size_t)g8::HALF * DM * 2, (size_t)g8::HALF * DM * 2, S, E);
        GRID_BAR(3);
    }
#endif
    if (IN(4)) {
#if !FAST_ROUTER
        router_simple(kparams(), vcu, G, lds);
#endif
        GRID_BAR(4);
    }
#if FAST_MOE
    if (IN(5)) {
        moe_build_table(kparams(), lds);
        const LAS int* tab = (const LAS int*)(lds + LDS_TAB);
        g8::MoeOrder<4, false> S{tab, G, vcu, (const char*)P->ws};
        g8::EpiUp E{tab, P};
        g8::gemm_phase<g8::EpiUp, g8::MoeOrder<4, false>, true>(lds, DM, (size_t)0, (size_t)(WS_WUT - WS_WGT), S, E);
        GRID_BAR(5);
    }
    if (IN(6)) {
        moe_build_table(kparams(), lds);
        const LAS int* tab = (const LAS int*)(lds + LDS_TAB);
        g8::MoeOrder<8, true> S{tab, G, vcu, (const char*)P->ws};
        g8::EpiDown E{tab, P};
        g8::gemm_phase<g8::EpiDown, g8::MoeOrder<8, true>, false>(lds, DE, (size_t)g8::HALF * DE * 2, (size_t)g8::HALF * DE * 2, S, E);
        GRID_BAR(6);
    }
#endif
    if (IN(7)) phase_final(kparams(), vcu, G);
#undef IN
#undef BOTH
#undef GRID_BAR
}

template <class AL, class BL, class EP>
__device__ __forceinline__ void gemm64_f32(int K, AL aload, BL bload, EP epi) {
    __shared__ float As[16][68];
    __shared__ float Bs[16][64];
    const int tid = threadIdx.x, ty = tid >> 4, tx = tid & 15;
    float acc[4][4];
#pragma unroll
    for (int i = 0; i < 4; ++i)
#pragma unroll
        for (int j = 0; j < 4; ++j) acc[i][j] = 0.f;
    const int am = tid >> 2, ak = (tid & 3) * 4;
    const int bk = tid >> 4, bn = (tid & 15) * 4;
    for (int k0 = 0; k0 < K; k0 += 16) {
        const float4 a = aload(am, k0 + ak);
        const float4 b = bload(k0 + bk, bn);
        __syncthreads();
        As[ak + 0][am] = a.x; As[ak + 1][am] = a.y; As[ak + 2][am] = a.z; As[ak + 3][am] = a.w;
        *(float4*)&Bs[bk][bn] = b;
        __syncthreads();
#pragma unroll
        for (int kk = 0; kk < 16; ++kk) {
            const float4 av = *(const float4*)&As[kk][ty * 4];
            const float4 bv = *(const float4*)&Bs[kk][tx * 4];
            const float aa[4] = {av.x, av.y, av.z, av.w};
            const float bb[4] = {bv.x, bv.y, bv.z, bv.w};
#pragma unroll
            for (int i = 0; i < 4; ++i)
#pragma unroll
                for (int j = 0; j < 4; ++j) acc[i][j] += aa[i] * bb[j];
        }
    }
#pragma unroll
    for (int i = 0; i < 4; ++i) epi(ty * 4 + i, tx * 4, make_float4(acc[i][0], acc[i][1], acc[i][2], acc[i][3]));
}
__device__ __forceinline__ float4 ld4bf(const bf16_t* p) { const v2u v = *(const v2u*)p; return make_float4(bf2f(v.x & 0xffffu), bf2f(v.x >> 16), bf2f(v.y & 0xffffu), bf2f(v.y >> 16)); }
__device__ __forceinline__ float4 ld4bt(const bf16_t* BT, int ldk, int n, int k) {
    return make_float4(bf2f(BT[(size_t)n * ldk + k]), bf2f(BT[(size_t)(n + 1) * ldk + k]), bf2f(BT[(size_t)(n + 2) * ldk + k]), bf2f(BT[(size_t)(n + 3) * ldk + k]));
}

__global__ void __launch_bounds__(256) n_gemm1(unsigned char* ws) {
    const bf16_t* Hb = (const bf16_t*)(ws + WS_HB); const bf16_t* WinT = (const bf16_t*)(ws + WS_WINT);
    float* VG = (float*)(ws + WS_VG); bf16_t* QKV = (bf16_t*)(ws + WS_QH);
    const int n0 = blockIdx.x * 64, m0 = blockIdx.y * 64;
    gemm64_f32(DM,
        [&](int m, int k) { return ld4bf(Hb + (size_t)(m0 + m) * DM + k); },
        [&](int k, int n) { return ld4bt(WinT, DM, n0 + n, k); },
        [&](int m, int n, float4 v) {
            const int c = n0 + n, row = m0 + m;
            if (c < 2048) { *(float4*)&VG[(size_t)row * 2048 + c] = v; }
            else { const int cq = c - 2048, which = cq >> 10, head = (cq & 1023) >> 6, d = cq & 63; const float sc = which == 0 ? QSCALE : 1.f;
                v2u o; o.x = pk2(v.x * sc, v.y * sc); o.y = pk2(v.z * sc, v.w * sc);
                *(v2u*)(QKV + (size_t)which * (NH * SEQ * HD) + ((size_t)head * SEQ + row) * HD + d) = o; } });
}
__global__ void __launch_bounds__(256) n_glu(unsigned char* ws) {
    const float* VG = (const float*)(ws + WS_VG); bf16_t* U = (bf16_t*)(ws + WS_U);
    const int idx = blockIdx.x * 256 + threadIdx.x; const int row = idx >> 10, c = idx & 1023;
    const int r0 = 256 * (c >> 7) + (c & 127);
    const float a = VG[(size_t)row * 2048 + r0], g = VG[(size_t)row * 2048 + r0 + 128];
    U[idx] = (bf16_t)f2bf(a * sigmoidf_(g));
}
__global__ void __launch_bounds__(256) n_attn(unsigned char* ws, const float* __restrict__ relb) {
    const bf16_t* Qh = (const bf16_t*)(ws + WS_QH); const bf16_t* Kh = (const bf16_t*)(ws + WS_KH); const bf16_t* Vh = (const bf16_t*)(ws + WS_VH);
    bf16_t* MIX = (bf16_t*)(ws + WS_MIX);
    const int t = blockIdx.x, h = blockIdx.y * 4 + (threadIdx.x >> 6), lane = threadIdx.x & 63;
    const int c = t >> 6, i = t & 63;
    const float qd = bf2f(Qh[((size_t)h * SEQ + t) * HD + lane]);
    float sc[9];
#pragma unroll
    for (int s = 0; s < 9; ++s) {
        const int ch = c - LEFT + s;
        float v = -1e30f;
        if (ch >= 0) {
            const int kpos = ch * 64 + lane;
            const bf16_t* kr = Kh + ((size_t)h * SEQ + kpos) * HD;
            float acc = 0.f;
            for (int d = 0; d < HD; d += 4) {
                const float4 kk = ld4bf(kr + d);
                acc += __shfl(qd, d) * kk.x + __shfl(qd, d + 1) * kk.y + __shfl(qd, d + 2) * kk.z + __shfl(qd, d + 3) * kk.w;
            }
            const int j = s * 64 + lane;
            int rel = LEFT * CHUNK + i - j; rel = rel < -RCLIP ? -RCLIP : (rel > RCLIP ? RCLIP : rel);
            v = acc + relb[h * NREL + rel + RCLIP] * LOG2E;
        }
        sc[s] = v;
    }
    float m = sc[0];
#pragma unroll
    for (int s = 1; s < 9; ++s) m = fmaxf(m, sc[s]);
    m = wave_max(m);
    float l = 0.f;
#pragma unroll
    for (int s = 0; s < 9; ++s) { const int ch = c - LEFT + s; sc[s] = (ch >= 0) ? exp2f(sc[s] - m) : 0.f; l += sc[s]; }
    l = wave_sum(l);
    float o = 0.f;
#pragma unroll
    for (int s = 0; s < 9; ++s) {
        const int ch = c - LEFT + s;
        if (ch >= 0) {
            const bf16_t* vr = Vh + ((size_t)h * SEQ + ch * 64) * HD + lane;
            for (int src = 0; src < 64; ++src) o += __shfl(sc[s], src) * bf2f(vr[(size_t)src * HD]);
        }
    }
    MIX[(size_t)t * DM + DCONV + h * HD + lane] = (bf16_t)f2bf(o / l);
}
__global__ void __launch_bounds__(256) n_gemm2(unsigned char* ws, const float* __restrict__ x, const float* __restrict__ g2) {
    const bf16_t* MIX = (const bf16_t*)(ws + WS_MIX); const bf16_t* WoutT = (const bf16_t*)(ws + WS_WOUTT);
    float* X1 = (float*)(ws + WS_X1); bf16_t* X1G = (bf16_t*)(ws + WS_X1G); float* SSP = (float*)(ws + WS_SSP);
    const int n0 = blockIdx.x * 64, m0 = blockIdx.y * 64;
    gemm64_f32(DM,
        [&](int m, int k) { return ld4bf(MIX + (size_t)(m0 + m) * DM + k); },
        [&](int k, int n) { return ld4bt(WoutT, DM, n0 + n, k); },
        [&](int m, int n, float4 v) {
            const size_t o = (size_t)(m0 + m) * DM + n0 + n; const float4 r = *(const float4*)&x[o]; const float4 g = *(const float4*)&g2[n0 + n];
            const float4 s = make_float4(r.x + v.x, r.y + v.y, r.z + v.z, r.w + v.w);
            *(float4*)&X1[o] = s;
            v2u pk; pk.x = pk2(s.x * g.x, s.y * g.y); pk.y = pk2(s.z * g.z, s.w * g.w); *(v2u*)(X1G + o) = pk;
            float q = s.x * s.x + s.y * s.y + s.z * s.z + s.w * s.w;
            q += __shfl_xor(q, 1); q += __shfl_xor(q, 2); q += __shfl_xor(q, 4); q += __shfl_xor(q, 8);
            if ((threadIdx.x & 15) == 0) SSP[(size_t)blockIdx.x * SEQ + m0 + m] = q; });
}
__global__ void __launch_bounds__(64) n_router(unsigned char* ws, const float* __restrict__ bg, const float* __restrict__ be) {
    __shared__ float hs[DM];
    const bf16_t* X1G = (const bf16_t*)(ws + WS_X1G); const float* SSP = (const float*)(ws + WS_SSP); const bf16_t* WrT = (const bf16_t*)(ws + WS_WRT);
    float* RSTD2 = (float*)(ws + WS_RSTD2); int* cnt = (int*)(ws + WS_CTL + CTL_CNT); int* ltk = (int*)(ws + WS_LTK); float* lgt = (float*)(ws + WS_LGT);
    const int t = blockIdx.x, lane = threadIdx.x;
    float ss = 0.f;
    for (int i = 0; i < 32; ++i) ss += SSP[(size_t)i * SEQ + t];
    const float rstd = rsqrtf(ss * (1.f / DM) + 1e-6f);
    if (lane == 0) RSTD2[t] = rstd;
    for (int i = 0; i < 32; ++i) { const int k = lane + 64 * i; hs[k] = bf2f(X1G[(size_t)t * DM + k]); }
    __syncthreads();
    float ae = 0.f, ag = 0.f;
    for (int k = 0; k < DM; ++k) { const float hv = hs[k]; ae += hv * bf2f(WrT[(size_t)(NG + lane) * DM + k]); ag += hv * bf2f(WrT[(size_t)(lane & 7) * DM + k]); }
    const float el = ae * rstd + be[lane], gl = ag * rstd + bg[lane & 7];
    float gmax = -INFINITY; int grp = 0;
    for (int g = 0; g < NG; ++g) { const float v = __shfl(gl, g); if (v > gmax) { gmax = v; grp = g; } }
    float sum = 0.f;
    for (int g = 0; g < NG; ++g) sum += __expf(__shfl(gl, g) - gmax);
    const float pgrp = 1.f / sum;
    float v0 = -INFINITY, v1 = -INFINITY; int i0 = 0, i1 = 0;
    for (int i = 0; i < EPG; ++i) {
        const float v = __shfl(el, grp * EPG + i);
        if (v > v0) { v1 = v0; i1 = i0; v0 = v; i0 = i; } else if (v > v1) { v1 = v; i1 = i; }
    }
    const float e1 = __expf(v1 - v0), inv = 1.f / (1.f + e1);
    if (lane == 0) {
        const int ea = grp * EPG + i0, eb = grp * EPG + i1;
        const int sa = atomicAdd(&cnt[ea], 1); ltk[ea * LCAP + sa] = t * 2 + 0; lgt[ea * LCAP + sa] = inv * pgrp;
        const int sb = atomicAdd(&cnt[eb], 1); ltk[eb * LCAP + sb] = t * 2 + 1; lgt[eb * LCAP + sb] = e1 * inv * pgrp;
    }
}
__global__ void __launch_bounds__(256) n_moe_up(unsigned char* ws) {
    const bf16_t* X1G = (const bf16_t*)(ws + WS_X1G); const float* RSTD2 = (const float*)(ws + WS_RSTD2);
    const int* cnt = (const int*)(ws + WS_CTL + CTL_CNT); const int* ltk = (const int*)(ws + WS_LTK);
    float* VG = (float*)(ws + WS_VG); bf16_t* HM = (bf16_t*)(ws + WS_HM);
    const int e = blockIdx.z, mt = blockIdx.y, nt = blockIdx.x;
    const int ce = cnt[e];
    if (mt * 64 >= ce) return;
    int ob = 0; for (int i = 0; i < e; ++i) ob += cnt[i];
    const int am = threadIdx.x >> 2; const int idx = mt * 64 + am;
    const int tok = idx < ce ? (ltk[e * LCAP + idx] >> 1) : -1;
    const bf16_t* WT = (const bf16_t*)(ws + (nt < 8 ? WS_WGT : WS_WUT)) + (size_t)e * DE * DM + (size_t)((nt & 7) * 64) * DM;
    gemm64_f32(DM,
        [&](int m, int k) { return tok >= 0 ? ld4bf(X1G + (size_t)tok * DM + k) : make_float4(0.f, 0.f, 0.f, 0.f); },
        [&](int k, int n) { return ld4bt(WT, DM, n, k); },
        [&](int m, int n, float4 v) { const int id = mt * 64 + m; if (id < ce) { const float rs = RSTD2[ltk[e * LCAP + id] >> 1];
            *(float4*)&VG[(size_t)(ob + id) * 1024 + nt * 64 + n] = make_float4(v.x * rs, v.y * rs, v.z * rs, v.w * rs); } });
    (void)HM;
}
__global__ void __launch_bounds__(256) n_moe_act(unsigned char* ws) {
    const float* VG = (const float*)(ws + WS_VG); bf16_t* HM = (bf16_t*)(ws + WS_HM);
    const int idx = blockIdx.x * 256 + threadIdx.x; const int row = idx >> 9, c = idx & 511;
    const float g = VG[(size_t)row * 1024 + c], u = VG[(size_t)row * 1024 + 512 + c];
    HM[idx] = (bf16_t)f2bf(g * sigmoidf_(g) * u);
}
__global__ void __launch_bounds__(256) n_moe_down(unsigned char* ws) {
    const bf16_t* HM = (const bf16_t*)(ws + WS_HM); const bf16_t* WdT = (const bf16_t*)(ws + WS_WDT);
    const int* cnt = (const int*)(ws + WS_CTL + CTL_CNT); const int* ltk = (const int*)(ws + WS_LTK); const float* lgt = (const float*)(ws + WS_LGT);
    bf16_t* Y = (bf16_t*)(ws + WS_Y);
    const int e = blockIdx.z, mt = blockIdx.y, nt = blockIdx.x;
    const int ce = cnt[e];
    if (mt * 64 >= ce) return;
    int ob = 0; for (int i = 0; i < e; ++i) ob += cnt[i];
    const int am = threadIdx.x >> 2; const int idx = mt * 64 + am;
    const bf16_t* WT = WdT + (size_t)e * DM * DE + (size_t)(nt * 64) * DE;
    gemm64_f32(DE,
        [&](int m, int k) { return idx < ce ? ld4bf(HM + (size_t)(ob + idx) * DE + k) : make_float4(0.f, 0.f, 0.f, 0.f); },
        [&](int k, int n) { return ld4bt(WT, DE, n, k); },
        [&](int m, int n, float4 v) {
            const int id = mt * 64 + m;
            if (id < ce) { const int tk = ltk[e * LCAP + id]; const float gt = lgt[e * LCAP + id];
                v2u o; o.x = pk2(gt * v.x, gt * v.y); o.y = pk2(gt * v.z, gt * v.w);
                *(v2u*)(Y + (size_t)tk * DM + nt * 64 + n) = o; } });
}

extern "C" void kernel_launch(void* const* d_in, const int* in_sizes, int n_in, void* d_out, int out_size, void* d_ws, size_t ws_size, hipStream_t stream) {
    static int grid = 0;
    if (grid == 0) {
        if (ws_size < WS_END) { fprintf(stderr, "kernel_launch: workspace too small (%zu < %zu)\n", ws_size, (size_t)WS_END); grid = -1; return; }
        int dev = 0, cus = 0, per_cu = 0;
        (void)hipGetDevice(&dev); (void)hipDeviceGetAttribute(&cus, hipDeviceAttributeMultiprocessorCount, dev);
        (void)hipFuncSetAttribute((const void*)mega, hipFuncAttributeMaxDynamicSharedMemorySize, LDS_BYTES);
        (void)hipOccupancyMaxActiveBlocksPerMultiprocessor(&per_cu, (const void*)mega, NTHR, LDS_BYTES);
        if (per_cu < 1) { fprintf(stderr, "kernel_launch: occupancy query says %d blocks per CU\n", per_cu); grid = -1; return; }
        grid = cus;
    }
    if (grid < 0) return;
    Params p{};
    p.x = (const float*)d_in[0]; p.norm1_g = (const float*)d_in[1]; p.w_in = (const float*)d_in[2]; p.w_dw = (const float*)d_in[3]; p.b_dw = (const float*)d_in[4];
    p.ln_g = (const float*)d_in[5]; p.ln_b = (const float*)d_in[6]; p.rel_bias = (const float*)d_in[7]; p.w_out = (const float*)d_in[8]; p.norm2_g = (const float*)d_in[9];
    p.w_group = (const float*)d_in[10]; p.b_group = (const float*)d_in[11]; p.w_er = (const float*)d_in[12]; p.b_er = (const float*)d_in[13];
    p.w_gate = (const float*)d_in[14]; p.w_up = (const float*)d_in[15]; p.w_down = (const float*)d_in[16]; p.final_g = (const float*)d_in[17];
    p.out = (float*)d_out; p.ws = (unsigned char*)d_ws;
    unsigned char* ws = (unsigned char*)d_ws;
    (void)hipMemsetAsync(ws + WS_CTL, 0, CTL_BYTES, stream);
    p.ph_lo = 0; p.ph_hi = 8; p.li = 0; p.pad = 0;
    hipLaunchKernelGGL(mega, dim3(grid), dim3(NTHR), LDS_BYTES, stream, p);
}
```

```cpp
#include <hip/hip_runtime.h>
#include <stdint.h>
#include <cstdio>

#ifndef FAST_GEMM1
#define FAST_GEMM1 1
#endif
#ifndef FAST_ATTN
#define FAST_ATTN 1
#endif
#ifndef FAST_GEMM2
#define FAST_GEMM2 1
#endif
#ifndef FAST_ROUTER
#define FAST_ROUTER 1
#endif
#ifndef FAST_MOE
#define FAST_MOE 1
#endif

#define LAS __attribute__((address_space(3)))
#define GAS __attribute__((address_space(1)))
typedef unsigned short bf16_t;
typedef unsigned v4u __attribute__((ext_vector_type(4)));
typedef unsigned v2u __attribute__((ext_vector_type(2)));
typedef float f32x4 __attribute__((ext_vector_type(4)));
typedef float f32x16 __attribute__((ext_vector_type(16)));
typedef short bf16x8 __attribute__((ext_vector_type(8)));

constexpr int DM = 2048, SEQ = 8192, DCONV = 1024, DATT = 1024, HD = 64, NH = 16, DIN = 5120;
constexpr int CHUNK = 64, LEFT = 8, RCLIP = 128, NREL = 257, CW = 31;
constexpr int NG = 8, EPG = 8, NE = 64, DE = 512;
constexpr int LCAP = 8192;
constexpr int NWAVES = 8, NTHR = 512;
constexpr float LOG2E = 1.4426950408889634f;
constexpr float QSCALE = 0.125f * LOG2E;
constexpr int NRT = 80;

constexpr size_t MiB = 1ull << 20;
constexpr size_t WS_CTL = 0, CTL_BYTES = 1 * MiB;
constexpr size_t CTL_CNT = 524288;
constexpr size_t WS_LTK = 1 * MiB, WS_LGT = 3 * MiB, WS_RSTD2 = 5 * MiB, WS_SSP = 6 * MiB, WS_WRT = 7 * MiB;
constexpr size_t WS_WINT = 8 * MiB, WS_WOUTT = 28 * MiB, WS_HB = 36 * MiB, WS_U = 68 * MiB;
constexpr size_t WS_QH = 84 * MiB, WS_KH = 100 * MiB, WS_VH = 116 * MiB, WS_MIX = 132 * MiB;
constexpr size_t WS_X1 = 164 * MiB, WS_X1G = 228 * MiB, WS_HM = 260 * MiB, WS_Y = 280 * MiB;
constexpr size_t WS_WGT = 344 * MiB, WS_WUT = 472 * MiB, WS_WDT = 600 * MiB, WS_VG = 728 * MiB, WS_END = 792 * MiB;

struct Params {
    const float *x, *norm1_g, *w_in, *w_dw, *b_dw, *ln_g, *ln_b, *rel_bias, *w_out, *norm2_g, *w_group, *b_group, *w_er, *b_er, *w_gate, *w_up, *w_down, *final_g;
    float* out; unsigned char* ws;
    int ph_lo, ph_hi, li, pad;
};

typedef const __attribute__((address_space(4))) Params* CParams;
__device__ __forceinline__ CParams kparams() { CParams kp = (CParams)__builtin_amdgcn_kernarg_segment_ptr(); asm volatile("" : "+s"(kp)); return kp; }
__device__ __forceinline__ CParams relaunder(CParams kp) { asm volatile("" : "+s"(kp)); return kp; }

__device__ __forceinline__ float bf2f(unsigned b) { return __uint_as_float(b << 16); }
__device__ __forceinline__ unsigned f2bf(float f) { unsigned u = __float_as_uint(f); return (u + 0x7fffu + ((u >> 16) & 1u)) >> 16; }
__device__ __forceinline__ unsigned pk2(float lo, float hi) { return f2bf(lo) | (f2bf(hi) << 16); }
__device__ __forceinline__ float wave_sum(float v) {
#pragma unroll
    for (int o = 1; o < 64; o <<= 1) v += __shfl_xor(v, o);
    return v;
}
__device__ __forceinline__ float wave_max(float v) {
#pragma unroll
    for (int o = 1; o < 64; o <<= 1) v = fmaxf(v, __shfl_xor(v, o));
    return v;
}
__device__ __forceinline__ float sigmoidf_(float x) { return 1.f / (1.f + __expf(-x)); }
__host__ __device__ __forceinline__ int wint_row(int n) {
    if (n < 1024) return 256 * (n >> 7) + (n & 127);
    if (n < 2048) { const int m = n - 1024; return 256 * (m >> 7) + 128 + (m & 127); }
    return n;
}

__device__ __forceinline__ void p0_transpose_item(const float* W, int ldw, int k0, int n0, bf16_t* WT, int K, int orow0, LAS float* scr, int lane) {
#pragma unroll 8
    for (int i = 0; i < 32; ++i) { const int kk = 2 * i + (lane >> 5); scr[kk * 33 + (lane & 31)] = W[(size_t)(k0 + kk) * ldw + n0 + (lane & 31)]; }
    asm volatile("s_waitcnt lgkmcnt(0)" ::: "memory");
    const int c = lane & 7;
#pragma unroll
    for (int j = 0; j < 4; ++j) { const int n = (lane >> 3) + 8 * j; const LAS float* s = scr + (8 * c) * 33 + n;
        v4u o; o.x = pk2(s[0 * 33], s[1 * 33]); o.y = pk2(s[2 * 33], s[3 * 33]); o.z = pk2(s[4 * 33], s[5 * 33]); o.w = pk2(s[6 * 33], s[7 * 33]);
        *(v4u*)(WT + (size_t)(orow0 + n) * K + k0 + 8 * c) = o; }
    asm volatile("s_waitcnt lgkmcnt(0)" ::: "memory");
}

__device__ __forceinline__ void phase_prologue(CParams P, int vcu, int G, LAS unsigned char* lds) {
    const int tid = threadIdx.x, lane = tid & 63, wave = __builtin_amdgcn_readfirstlane(tid >> 6);
    LAS float* scr = (LAS float*)(lds + wave * 16384);
    const int gw = vcu * NWAVES + wave, NGW = G * NWAVES;
    bf16_t* WinT = (bf16_t*)(P->ws + WS_WINT); bf16_t* WoutT = (bf16_t*)(P->ws + WS_WOUTT); bf16_t* WrT = (bf16_t*)(P->ws + WS_WRT);
    bf16_t* Hb = (bf16_t*)(P->ws + WS_HB);
    bf16_t* WgT = (bf16_t*)(P->ws + WS_WGT); bf16_t* WuT = (bf16_t*)(P->ws + WS_WUT); bf16_t* WdT = (bf16_t*)(P->ws + WS_WDT);
    for (int m = gw; m < SEQ; m += NGW) {
        const f32x4* xr = (const f32x4*)(P->x + (size_t)m * DM) + lane; const f32x4* gr = (const f32x4*)P->norm1_g + lane;
        f32x4 v[8]; float s = 0.f;
#pragma unroll
        for (int j = 0; j < 8; ++j) { v[j] = xr[64 * j]; s += (v[j].x * v[j].x + v[j].y * v[j].y) + (v[j].z * v[j].z + v[j].w * v[j].w); }
        const float rstd = rsqrtf(wave_sum(s) * (1.f / DM) + 1e-6f);
        v2u* o8 = (v2u*)(Hb + (size_t)m * DM) + lane;
#pragma unroll
        for (int j = 0; j < 8; ++j) { const f32x4 g = gr[64 * j]; v2u o; o.x = pk2(v[j].x * rstd * g.x, v[j].y * rstd * g.y); o.y = pk2(v[j].z * rstd * g.z, v[j].w * rstd * g.w); o8[64 * j] = o; }
    }
    constexpr int I_IN = (DM / 64) * (DIN / 32), I_OUT = (DM / 64) * (DM / 32), I_GU = (DM / 64) * (DE / 32), I_DN = (DE / 64) * (DM / 32);
    constexpr int NITEMS = I_IN + I_OUT + NE * (2 * I_GU + I_DN);
    for (int it = gw; it < NITEMS; it += NGW) {
        int r = it;
        if (r < I_IN) { const int nb = r % (DIN / 32), kb = r / (DIN / 32); p0_transpose_item(P->w_in, DIN, 64 * kb, 32 * nb, WinT, DM, wint_row(32 * nb), scr, lane); continue; } r -= I_IN;
        if (r < I_OUT) { const int nb = r % (DM / 32), kb = r / (DM / 32); p0_transpose_item(P->w_out, DM, 64 * kb, 32 * nb, WoutT, DM, 32 * nb, scr, lane); continue; } r -= I_OUT;
        const int e = r / (2 * I_GU + I_DN); r -= e * (2 * I_GU + I_DN);
        if (r < I_GU) { const int nb = r % (DE / 32), kb = r / (DE / 32); p0_transpose_item(P->w_gate + (size_t)e * DM * DE, DE, 64 * kb, 32 * nb, WgT + (size_t)e * DE * DM, DM, 32 * nb, scr, lane); continue; } r -= I_GU;
        if (r < I_GU) { const int nb = r % (DE / 32), kb = r / (DE / 32); p0_transpose_item(P->w_up + (size_t)e * DM * DE, DE, 64 * kb, 32 * nb, WuT + (size_t)e * DE * DM, DM, 32 * nb, scr, lane); continue; } r -= I_GU;
        { const int nb = r % (DM / 32), kb = r / (DM / 32); p0_transpose_item(P->w_down + (size_t)e * DE * DM, DM, 64 * kb, 32 * nb, WdT + (size_t)e * DM * DE, DE, 32 * nb, scr, lane); }
    }
    for (int idx = (vcu * NTHR + tid); idx < NRT * DM; idx += G * NTHR) {
        const int n = idx / DM, k = idx % DM;
        float v = 0.f; if (n < NG) v = P->w_group[k * NG + n]; else if (n < NG + NE) v = P->w_er[k * NE + (n - NG)];
        WrT[idx] = (bf16_t)f2bf(v);
    }
}

constexpr int CONV_T = 16, CONV_ROWS = CONV_T + CW - 1;
constexpr int CONV_LDS_RED = 96 * 1024;
__device__ __forceinline__ void conv_item(CParams P, int item, LAS unsigned char* lds) {
    const int tid = threadIdx.x, lane = tid & 63, wave = tid >> 6;
    const bf16_t* U = (const bf16_t*)(P->ws + WS_U); bf16_t* MIX = (bf16_t*)(P->ws + WS_MIX);
    const int t0 = item * CONV_T;
    __syncthreads();
    for (int idx = tid; idx < CONV_ROWS * 128; idx += NTHR) {
        const int r = idx >> 7, ch = idx & 127, t = t0 - (CW - 1) + r;
        v4u v = {0u, 0u, 0u, 0u}; if (t >= 0) v = *(const v4u*)(U + (size_t)t * DCONV + ch * 8);
        *(LAS v4u*)(lds + r * 2048 + ch * 16) = v;
    }
    float w0[CW], w1[CW];
#pragma unroll
    for (int j = 0; j < CW; ++j) { const float2 w = *(const float2*)(P->w_dw + j * DCONV + 2 * tid); w0[j] = w.x; w1[j] = w.y; }
    const float2 bb = *(const float2*)(P->b_dw + 2 * tid);
    float a0[CONV_T], a1[CONV_T];
#pragma unroll
    for (int t = 0; t < CONV_T; ++t) { a0[t] = bb.x; a1[t] = bb.y; }
    __syncthreads();
#pragma unroll
    for (int r = 0; r < CONV_ROWS; ++r) {
        const unsigned u2 = *(const LAS unsigned*)(lds + r * 2048 + tid * 4);
        const float ua = bf2f(u2 & 0xffffu), ub = bf2f(u2 >> 16);
#pragma unroll
        for (int t = 0; t < CONV_T; ++t) { const int j = r - t; if (j >= 0 && j < CW) { a0[t] += w0[j] * ua; a1[t] += w1[j] * ub; } }
    }
    LAS float* red = (LAS float*)(lds + CONV_LDS_RED);
    LAS float* st = red + NWAVES * CONV_T * 2;
#pragma unroll
    for (int t = 0; t < CONV_T; ++t) {
        const float s = wave_sum(a0[t] + a1[t]), q = wave_sum(a0[t] * a0[t] + a1[t] * a1[t]);
        if (lane == 0) { red[(wave * CONV_T + t) * 2] = s; red[(wave * CONV_T + t) * 2 + 1] = q; }
    }
    __syncthreads();
    if (tid < CONV_T) {
        float s = 0.f, q = 0.f;
        for (int w = 0; w < NWAVES; ++w) { s += red[(w * CONV_T + tid) * 2]; q += red[(w * CONV_T + tid) * 2 + 1]; }
        const float mu = s * (1.f / DCONV), var = fmaxf(q * (1.f / DCONV) - mu * mu, 0.f);
        st[tid * 2] = mu; st[tid * 2 + 1] = rsqrtf(var + 1e-5f);
    }
    __syncthreads();
    const float2 lg = *(const float2*)(P->ln_g + 2 * tid), lb = *(const float2*)(P->ln_b + 2 * tid);
#pragma unroll
    for (int t = 0; t < CONV_T; ++t) {
        const float mu = st[t * 2], rs = st[t * 2 + 1];
        const float u0 = (a0[t] - mu) * rs * lg.x + lb.x, u1 = (a1[t] - mu) * rs * lg.y + lb.y;
        *(unsigned*)(MIX + (size_t)(t0 + t) * DM + 2 * tid) = pk2(u0 * sigmoidf_(u0), u1 * sigmoidf_(u1));
    }
}

__device__ __forceinline__ void phase_final(CParams P, int vcu, int G) {
    const int tid = threadIdx.x, lane = tid & 63, wave = tid >> 6;
    const float* X1 = (const float*)(P->ws + WS_X1); const bf16_t* Y = (const bf16_t*)(P->ws + WS_Y);
    for (int m = vcu * NWAVES + wave; m < SEQ; m += G * NWAVES) {
        const f32x4* xr = (const f32x4*)(X1 + (size_t)m * DM) + lane;
        const v2u* y0 = (const v2u*)(Y + (size_t)(2 * m) * DM) + lane; const v2u* y1 = (const v2u*)(Y + (size_t)(2 * m + 1) * DM) + lane;
        f32x4 v[8]; float s = 0.f;
#pragma unroll
        for (int j = 0; j < 8; ++j) {
            v[j] = xr[64 * j]; const v2u a = y0[64 * j], b = y1[64 * j];
            v[j].x += bf2f(a.x & 0xffffu) + bf2f(b.x & 0xffffu); v[j].y += bf2f(a.x >> 16) + bf2f(b.x >> 16);
            v[j].z += bf2f(a.y & 0xffffu) + bf2f(b.y & 0xffffu); v[j].w += bf2f(a.y >> 16) + bf2f(b.y >> 16);
            s += (v[j].x * v[j].x + v[j].y * v[j].y) + (v[j].z * v[j].z + v[j].w * v[j].w);
        }
        const float rstd = rsqrtf(wave_sum(s) * (1.f / DM) + 1e-6f);
        f32x4* o = (f32x4*)(P->out + (size_t)m * DM) + lane; const f32x4* g = (const f32x4*)P->final_g + lane;
#pragma unroll
        for (int j = 0; j < 8; ++j) o[64 * j] = v[j] * rstd * g[64 * j];
    }
}

namespace g8 {
constexpr int BM = 256, BK = 64, HALF = 128, HTB = HALF * BK * 2, STAGE_BYTES = 8 * HTB, NXCD = 8, WGM = 8;
__host__ __device__ __forceinline__ int lds_byte(int r, int c) { const int st = (r >> 4) * 2 + (c >> 5), rr = r & 15, cc = c & 31, ob = rr * 64 + cc * 2; return st * 1024 + (ob ^ (((ob >> 9) & 1) << 5)); }
__host__ __device__ __forceinline__ void stage_rc(int b, int& R, int& C) { const int st = b / 1024, sb = b % 1024, swz = sb ^ (((sb >> 9) & 1) << 5); R = (st >> 1) * 16 + swz / 64; C = (st & 1) * 32 + (swz % 64) / 2; }
__host__ __device__ __forceinline__ int perm32(int rho) { const int n = rho >> 4, i = rho & 15; return 8 * (i >> 2) + 4 * n + (i & 3); }
__device__ __forceinline__ unsigned cvt_pk_bf16(float lo, float hi) { unsigned r; asm volatile("v_cvt_pk_bf16_f32 %0, %1, %2" : "=v"(r) : "v"(lo), "v"(hi)); return r; }

struct Unit { const char* a; const char* b; int i0, i1, i2; };

template <class Epi, class Sched, bool GATHER>
__device__ __forceinline__ void gemm_phase(LAS unsigned char* lds, const int K, const size_t astep, const size_t bstep, const Sched& S, const Epi& E) {
    const int tid = threadIdx.x, wid = __builtin_amdgcn_readfirstlane(tid >> 6), lane = tid & 63, wr = wid >> 2, wc = wid & 3, fr = lane & 15, fq = lane >> 4;
    const int nt = K / BK;
    unsigned voffB[2], voffA0[2], voffA1[2];
#pragma unroll
    for (int i = 0; i < 2; ++i) { int R, C; stage_rc(tid * 16 + i * 8192, R, C); const int Rb = (R & ~31) + perm32(R & 31);
        voffB[i] = (unsigned)(Rb * K + C) * 2u; voffA0[i] = (unsigned)(R * K + C) * 2u; voffA1[i] = voffA0[i]; }
    const size_t kstep = (size_t)(BK * 2);
    const unsigned ldsw = (unsigned)wid * 1024u;
    const int aoff = lds_byte(wr * 64 + fr, fq * 8), boff = lds_byte(wc * 32 + fr, fq * 8);
#define G8_SA(b, h) (((b) * 2 + (h)) * HTB)
#define G8_SB(b, h) ((4 + (b) * 2 + (h)) * HTB)
#define G8_STAGE(bufoff, gbase, voff) do { _Pragma("unroll") for (int _i = 0; _i < 2; ++_i) \
        __builtin_amdgcn_global_load_lds((const unsigned*)((const char*)(gbase) + (voff)[_i]), (LAS unsigned*)(lds + (bufoff) + ldsw + _i * 8192), 16, 0, 0); } while (0)
#define G8_LDA(dst, b, h) do { _Pragma("unroll") for (int m = 0; m < 4; ++m) _Pragma("unroll") for (int k = 0; k < 2; ++k) dst[m][k] = *(const LAS bf16x8*)(lds + G8_SA(b, h) + aoff + m * 2048 + k * 1024); } while (0)
#define G8_LDB(dst, b, h) do { _Pragma("unroll") for (int n = 0; n < 2; ++n) _Pragma("unroll") for (int k = 0; k < 2; ++k) dst[n][k] = *(const LAS bf16x8*)(lds + G8_SB(b, h) + boff + n * 2048 + k * 1024); } while (0)
#define G8_MMA(ai, bj, At, Bt) do { __builtin_amdgcn_s_setprio(1); _Pragma("unroll") for (int m = 0; m < 4; ++m) _Pragma("unroll") for (int n = 0; n < 2; ++n) _Pragma("unroll") for (int k = 0; k < 2; ++k) \
        acc[ai][bj][m][n] = __builtin_amdgcn_mfma_f32_16x16x32_bf16(Bt[n][k], At[m][k], acc[ai][bj][m][n], 0, 0, 0); __builtin_amdgcn_s_setprio(0); } while (0)
#define G8_WAIT_V(n) asm volatile("s_waitcnt vmcnt(" #n ")" ::: "memory")
#define G8_WAIT_L(n) asm volatile("s_waitcnt lgkmcnt(" #n ")" ::: "memory")
#define G8_BAR __builtin_amdgcn_s_barrier()
#define G8_SCHED __builtin_amdgcn_sched_barrier(0)
#define G8_GOFF(u) do { if (GATHER) { _Pragma("unroll") for (int _i = 0; _i < 2; ++_i) { int R_, C_; stage_rc(tid * 16 + _i * 8192, R_, C_); \
        voffA0[_i] = S.row_off(u, R_) + (unsigned)C_ * 2u; voffA1[_i] = S.row_off(u, R_ + HALF) + (unsigned)C_ * 2u; } } } while (0)
    Unit cur, nxt; int ui = 0;
    if (!S.next(0, cur)) return;
    f32x4 acc[2][2][4][2];
#pragma unroll
    for (int a = 0; a < 2; ++a)
#pragma unroll
        for (int b = 0; b < 2; ++b)
#pragma unroll
            for (int m = 0; m < 4; ++m)
#pragma unroll
                for (int n = 0; n < 2; ++n) acc[a][b][m][n] = (f32x4){0.f, 0.f, 0.f, 0.f};
    bf16x8 At[4][2], B0[2][2], B1[2][2];
    const char* cA0 = cur.a; const char* cB0 = cur.b;
#define cA1 (cA0 + astep)
#define cB1 (cB0 + bstep)
    G8_GOFF(cur);
    G8_STAGE(G8_SB(0, 0), cB0, voffB); G8_STAGE(G8_SB(0, 1), cB1, voffB); G8_STAGE(G8_SA(0, 0), cA0, voffA0); G8_STAGE(G8_SA(0, 1), cA1, voffA1);
    if (wr == 1) G8_BAR;
    G8_WAIT_V(2); G8_BAR;
    G8_STAGE(G8_SB(1, 0), cB0 + kstep, voffB); G8_STAGE(G8_SA(1, 0), cA0 + kstep, voffA0); G8_STAGE(G8_SB(1, 1), cB1 + kstep, voffB);
    G8_WAIT_V(6); G8_BAR;
    for (;;) {
        const bool has_next = S.next(ui + 1, nxt);
        const char* nA0 = has_next ? nxt.a : cA0; const char* nB0 = has_next ? nxt.b : cB0;
        for (int t = 0; t < nt; t += 2) {
            const bool last = (t == nt - 2);
            const char* a1h = cA1 + (size_t)(t + 1) * kstep;
            const char* a2_0 = last ? nA0 : cA0 + (size_t)(t + 2) * kstep; const char* a2_1 = a2_0 + astep;
            const char* b2_0 = last ? nB0 : cB0 + (size_t)(t + 2) * kstep; const char* b2_1 = b2_0 + bstep;
            const char* a3_0 = a2_0 + kstep; const char* b3_0 = b2_0 + kstep; const char* b3_1 = b2_1 + kstep;
            G8_LDB(B0, 0, 0); G8_LDB(B1, 0, 1); G8_SCHED; G8_LDA(At, 0, 0); G8_STAGE(G8_SA(1, 1), a1h, voffA1);
            G8_WAIT_V(8); G8_WAIT_L(0); G8_BAR; G8_MMA(0, 0, At, B0); G8_MMA(0, 1, At, B1); G8_BAR; G8_SCHED;
            if (GATHER) { if (last && has_next) { G8_GOFF(nxt); } }
            G8_LDA(At, 0, 1); G8_STAGE(G8_SB(0, 0), b2_0, voffB); G8_STAGE(G8_SB(0, 1), b2_1, voffB); G8_STAGE(G8_SA(0, 0), a2_0, voffA0);
            G8_WAIT_V(8); G8_WAIT_L(0); G8_BAR; G8_MMA(1, 0, At, B0); G8_MMA(1, 1, At, B1); G8_BAR; G8_SCHED;
            G8_LDB(B0, 1, 0); G8_LDB(B1, 1, 1); G8_SCHED; G8_LDA(At, 1, 0); G8_STAGE(G8_SA(0, 1), a2_1, voffA1);
            G8_WAIT_V(8); G8_WAIT_L(0); G8_BAR; G8_MMA(0, 0, At, B0); G8_MMA(0, 1, At, B1); G8_BAR; G8_SCHED;
            G8_LDA(At, 1, 1); G8_STAGE(G8_SB(1, 0), b3_0, voffB); G8_STAGE(G8_SB(1, 1), b3_1, voffB); G8_STAGE(G8_SA(1, 0), a3_0, voffA0);
            G8_WAIT_V(8); G8_WAIT_L(0); G8_BAR; G8_MMA(1, 0, At, B0); G8_MMA(1, 1, At, B1); G8_BAR; G8_SCHED;
        }
        if (wr == 0) G8_BAR;
        E(acc, cur, wr, wc, fr, fq);
        if (!has_next) break;
#pragma unroll
        for (int a = 0; a < 2; ++a)
#pragma unroll
            for (int b = 0; b < 2; ++b)
#pragma unroll
                for (int m = 0; m < 4; ++m)
#pragma unroll
                    for (int n = 0; n < 2; ++n) acc[a][b][m][n] = (f32x4){0.f, 0.f, 0.f, 0.f};
        cur = nxt; cA0 = nA0; cB0 = nB0; ++ui;
        if (wr == 1) G8_BAR;
    }
    G8_WAIT_V(0);
    G8_BAR;
#undef G8_SA
#undef G8_SB
#undef G8_STAGE
#undef G8_LDA
#undef G8_LDB
#undef G8_MMA
#undef G8_WAIT_V
#undef G8_WAIT_L
#undef G8_BAR
#undef G8_SCHED
#undef G8_GOFF
#undef cA1
#undef cB1
}

struct DenseOrder {
    int nM, nN, nwg, G, c, K; const char* A; const char* Bt;
    __device__ __forceinline__ void init(const void* A_, const void* Bt_, int M, int N, int K_, int G_, int c_) { A = (const char*)A_; Bt = (const char*)Bt_; nM = M / BM; nN = N / BM; nwg = nM * nN; G = G_; c = c_; K = K_; }
    __device__ __forceinline__ bool next(int i, Unit& u) const {
        const long L = (long)i * G + c; if (L >= nwg) return false;
        int wgid = (int)L; { const int q = nwg / NXCD, r = nwg % NXCD, xcd = wgid % NXCD, off = wgid / NXCD; wgid = (xcd < r ? xcd * (q + 1) : r * (q + 1) + (xcd - r) * q) + off; }
        const int nig = WGM * nN, gid = wgid / nig, fm = gid * WGM, gsz = (nM - fm) < WGM ? (nM - fm) : WGM;
        const int pm = fm + ((wgid % nig) % gsz), pn = (wgid % nig) / gsz;
        const size_t hstep = (size_t)HALF * K * 2;
        u.a = A + (size_t)pm * 2 * hstep; u.b = Bt + (size_t)pn * 2 * hstep; u.i0 = pm; u.i1 = pn; u.i2 = 0; return true;
    }
    __device__ __forceinline__ unsigned row_off(const Unit&, int) const { return 0u; }
};

struct EpiIn {
    CParams P;
    __device__ __forceinline__ void operator()(const f32x4 (&acc)[2][2][4][2], const Unit& u, int wr, int wc, int fr, int fq) const {
        unsigned char* ws = relaunder(P)->ws;
        bf16_t* U = (bf16_t*)(ws + WS_U); bf16_t* QKV = (bf16_t*)(ws + WS_QH);
        const int pm = u.i0, pn = u.i1;
        const int row0 = pm * BM + wr * 64 + fr;
        if (pn < 8) {
            bf16_t* base = U + (size_t)row0 * DCONV + pn * 128 + wc * 32 + 8 * fq;
#pragma unroll
            for (int ai = 0; ai < 2; ++ai)
#pragma unroll
                for (int m = 0; m < 4; ++m) {
                    float r[8];
#pragma unroll
                    for (int n = 0; n < 2; ++n)
#pragma unroll
                        for (int i = 0; i < 4; ++i) { const float v = acc[ai][0][m][n][i], g = acc[ai][1][m][n][i]; r[4 * n + i] = v * __builtin_amdgcn_rcpf(1.f + __expf(-g)); }
                    v4u w; w.x = cvt_pk_bf16(r[0], r[1]); w.y = cvt_pk_bf16(r[2], r[3]); w.z = cvt_pk_bf16(r[4], r[5]); w.w = cvt_pk_bf16(r[6], r[7]);
                    *(v4u*)(base + (size_t)(ai * HALF + m * 16) * DCONV) = w;
                }
        } else {
            const int which = (pn - 8) >> 2, hq = 4 * ((pn - 8) & 3) + (wc >> 1);
            const float sc = which == 0 ? QSCALE : 1.f;
            bf16_t* base = QKV + (size_t)which * ((size_t)NH * SEQ * HD) + (size_t)row0 * HD + (wc & 1) * 32 + 8 * fq;
#pragma unroll
            for (int ai = 0; ai < 2; ++ai)
#pragma unroll
                for (int m = 0; m < 4; ++m)
#pragma unroll
                    for (int bj = 0; bj < 2; ++bj) {
                        const f32x4 v0 = acc[ai][bj][m][0] * sc, v1 = acc[ai][bj][m][1] * sc;
                        v4u w; w.x = cvt_pk_bf16(v0[0], v0[1]); w.y = cvt_pk_bf16(v0[2], v0[3]); w.z = cvt_pk_bf16(v1[0], v1[1]); w.w = cvt_pk_bf16(v1[2], v1[3]);
                        *(v4u*)(base + ((size_t)(hq + 2 * bj) * SEQ + ai * HALF + m * 16) * HD) = w;
                    }
        }
    }
};
struct EpiOut {
    CParams P;
    __device__ __forceinline__ void operator()(const f32x4 (&acc)[2][2][4][2], const Unit& u, int wr, int wc, int fr, int fq) const {
        CParams Q = relaunder(P);
        const float* x = Q->x; const float* g2 = Q->norm2_g; unsigned char* ws = Q->ws;
        float* X1 = (float*)(ws + WS_X1); bf16_t* X1G = (bf16_t*)(ws + WS_X1G); float* SSP = (float*)(ws + WS_SSP);
        const int pm = u.i0, pn = u.i1;
        const int row0 = pm * BM + wr * 64 + fr, col0 = pn * BM + wc * 32 + 8 * fq;
        f32x4 gv[2][2];
#pragma unroll
        for (int bj = 0; bj < 2; ++bj)
#pragma unroll
            for (int n = 0; n < 2; ++n) gv[bj][n] = *(const f32x4*)(g2 + col0 + bj * HALF + 4 * n);
#pragma unroll
        for (int ai = 0; ai < 2; ++ai)
#pragma unroll
            for (int m = 0; m < 4; ++m) {
                const int row = row0 + ai * HALF + m * 16; const size_t off = (size_t)row * DM + col0;
                float q = 0.f;
#pragma unroll
                for (int bj = 0; bj < 2; ++bj) {
                    const f32x4 s0 = *(const f32x4*)(x + off + bj * HALF) + acc[ai][bj][m][0], s1 = *(const f32x4*)(x + off + bj * HALF + 4) + acc[ai][bj][m][1];
                    *(f32x4*)(X1 + off + bj * HALF) = s0; *(f32x4*)(X1 + off + bj * HALF + 4) = s1;
                    q += (s0[0] * s0[0] + s0[1] * s0[1]) + (s0[2] * s0[2] + s0[3] * s0[3]) + (s1[0] * s1[0] + s1[1] * s1[1]) + (s1[2] * s1[2] + s1[3] * s1[3]);
                    const f32x4 t0 = s0 * gv[bj][0], t1 = s1 * gv[bj][1];
                    v4u w; w.x = cvt_pk_bf16(t0[0], t0[1]); w.y = cvt_pk_bf16(t0[2], t0[3]); w.z = cvt_pk_bf16(t1[0], t1[1]); w.w = cvt_pk_bf16(t1[2], t1[3]);
                    *(v4u*)(X1G + off + bj * HALF) = w;
                }
                q += __shfl_xor(q, 16); q += __shfl_xor(q, 32);
                if (fq == 0) SSP[(size_t)(pn * 4 + wc) * SEQ + row] = q;
            }
    }
};
constexpr int TAB_TS = 0, TAB_OS = 65, TAB_CN = 130;
template <int NT, bool DOWN>
struct MoeOrder {
    const LAS int* tab; int G, c; const char* wsb;
    __device__ __forceinline__ bool next(int i, Unit& u) const {
        const int L = i * G + c; const int T = L / NT, nt = L % NT;
        if (T >= tab[TAB_TS + NE]) return false;
        int e = 0;
        for (int j = 1; j < NE; ++j) e += (tab[TAB_TS + j] <= T) ? 1 : 0;
        e = __builtin_amdgcn_readfirstlane(e);
        const int mt = __builtin_amdgcn_readfirstlane(T - tab[TAB_TS + e]);
        const char* Abase = wsb + (DOWN ? WS_HM : WS_X1G); const char* Bbase = wsb + (DOWN ? WS_WDT : WS_WGT);
        if (DOWN) {
            const int ob = __builtin_amdgcn_readfirstlane(tab[TAB_OS + e]);
            u.a = Abase + (size_t)(ob + mt * BM) * (DE * 2);
            u.b = Bbase + (size_t)e * ((size_t)DM * DE * 2) + (size_t)nt * ((size_t)BM * DE * 2);
        } else {
            u.a = Abase;
            u.b = Bbase + (size_t)e * ((size_t)DE * DM * 2) + (size_t)nt * ((size_t)HALF * DM * 2);
        }
        u.i0 = e; u.i1 = mt; u.i2 = nt; return true;
    }
    __device__ __forceinline__ unsigned row_off(const Unit& u, int r) const {
        const int ce = tab[TAB_CN + u.i0]; int idx = u.i1 * BM + r; idx = idx < ce ? idx : ce - 1;
        return (unsigned)(((const int*)(wsb + WS_LTK))[u.i0 * LCAP + idx] >> 1) * (unsigned)(DM * 2);
    }
};
struct EpiUp {
    const LAS int* tab; CParams P;
    __device__ __forceinline__ void operator()(const f32x4 (&acc)[2][2][4][2], const Unit& u, int wr, int wc, int fr, int fq) const {
        unsigned char* ws = relaunder(P)->ws;
        const int* ltk = (const int*)(ws + WS_LTK); const float* rstd2 = (const float*)(ws + WS_RSTD2); bf16_t* HM = (bf16_t*)(ws + WS_HM);
        const int e = u.i0, mt = u.i1, nt = u.i2; const int ce = tab[TAB_CN + e], ob = tab[TAB_OS + e];
#pragma unroll
        for (int ai = 0; ai < 2; ++ai)
#pragma unroll
            for (int m = 0; m < 4; ++m) {
                const int idx = mt * BM + ai * HALF + wr * 64 + m * 16 + fr;
                if (idx < ce) {
                    const float rs = rstd2[ltk[e * LCAP + idx] >> 1];
                    float h[8];
#pragma unroll
                    for (int n = 0; n < 2; ++n)
#pragma unroll
                        for (int i = 0; i < 4; ++i) { const float g = acc[ai][0][m][n][i] * rs, uu = acc[ai][1][m][n][i] * rs; h[4 * n + i] = g * __builtin_amdgcn_rcpf(1.f + __expf(-g)) * uu; }
                    v4u w; w.x = cvt_pk_bf16(h[0], h[1]); w.y = cvt_pk_bf16(h[2], h[3]); w.z = cvt_pk_bf16(h[4], h[5]); w.w = cvt_pk_bf16(h[6], h[7]);
                    *(v4u*)(HM + (size_t)(ob + idx) * DE + nt * HALF + wc * 32 + 8 * fq) = w;
                }
            }
    }
};
struct EpiDown {
    const LAS int* tab; CParams P;
    __device__ __forceinline__ void operator()(const f32x4 (&acc)[2][2][4][2], const Unit& u, int wr, int wc, int fr, int fq) const {
        unsigned char* ws = relaunder(P)->ws;
        const int* ltk = (const int*)(ws + WS_LTK); const float* lgt = (const float*)(ws + WS_LGT); bf16_t* Y = (bf16_t*)(ws + WS_Y);
        const int e = u.i0, mt = u.i1, nt = u.i2; const int ce = tab[TAB_CN + e];
#pragma unroll
        for (int ai = 0; ai < 2; ++ai)
#pragma unroll
            for (int m = 0; m < 4; ++m) {
                const int idx = mt * BM + ai * HALF + wr * 64 + m * 16 + fr;
                if (idx < ce) {
                    const int tk = ltk[e * LCAP + idx]; const float gt = lgt[e * LCAP + idx];
                    bf16_t* rowp = Y + (size_t)tk * DM + nt * BM + wc * 32 + 8 * fq;
#pragma unroll
                    for (int bj = 0; bj < 2; ++bj) {
                        const f32x4 v0 = acc[ai][bj][m][0] * gt, v1 = acc[ai][bj][m][1] * gt;
                        v4u w; w.x = cvt_pk_bf16(v0[0], v0[1]); w.y = cvt_pk_bf16(v0[2], v0[3]); w.z = cvt_pk_bf16(v1[0], v1[1]); w.w = cvt_pk_bf16(v1[2], v1[3]);
                        *(v4u*)(rowp + bj * HALF) = w;
                    }
                }
            }
    }
};
}


#define XB_TMO      128
#define XB_XCNT(j)  (256  + 64 * (j))
#define XB_XSUB(j)  (1280 + 64 * (j))
#define XB_XGEN(j)  (2304 + 64 * (j))
#define XB_TOP      3328
#define XB_TOPGEN   3392
#define XCD_BAR_WORDS 3456
#define XB_SPIN_CAP (1u << 18)
__device__ __forceinline__ unsigned xb_ld(unsigned* p)              { return __hip_atomic_load(p, __ATOMIC_RELAXED, __HIP_MEMORY_SCOPE_AGENT); }
__device__ __forceinline__ unsigned xb_add(unsigned* p, unsigned v) { return __hip_atomic_fetch_add(p, v, __ATOMIC_RELAXED, __HIP_MEMORY_SCOPE_AGENT); }
__device__ __forceinline__ unsigned xb_xcc_id() { return (unsigned)__builtin_amdgcn_s_getreg((3 << 11) | 20) & 0xFu; }
#define XB_SPIN(cond, bar) do { unsigned _sp = 0; while (cond) { __builtin_amdgcn_s_sleep(1); \
    if ((++_sp & 255u) == 0u) { if (xb_ld(&(bar)[XB_TMO])) break; if (_sp > XB_SPIN_CAP) { atomicAdd(&(bar)[XB_TMO], 1u); break; } } } } while (0)
struct XcdBarrier { unsigned* bar; unsigned x; volatile LAS unsigned* st; };
__device__ __forceinline__ XcdBarrier xcd_barrier_post(unsigned* bar, volatile LAS unsigned* st) {
    XcdBarrier b; b.bar = bar; b.x = xb_xcc_id(); b.st = st;
    if (threadIdx.x == 0) (void)xb_add(&bar[XB_XCNT(b.x)], 1u);
    return b;
}
__device__ __forceinline__ void xcd_barrier_complete(unsigned* bar, unsigned x, unsigned& nloc, unsigned& nx) {
    const unsigned G = gridDim.x * gridDim.y * gridDim.z;
    unsigned sum, cnt, mine, sp = 0u;
    for (;;) {
        sum = 0u; cnt = 0u; mine = 0u;
#pragma unroll
        for (unsigned j = 0; j < 16; ++j) { const unsigned c = xb_ld(&bar[XB_XCNT(j)]); sum += c; cnt += (c > 0u) ? 1u : 0u; mine = (j == x) ? c : mine; }
        if (sum == G) break;
        __builtin_amdgcn_s_sleep(1);
        if ((++sp & 255u) == 0u) { if (xb_ld(&bar[XB_TMO])) break; if (sp > XB_SPIN_CAP) { atomicAdd(&bar[XB_TMO], 1u); break; } }
    }
    nloc = mine > 0u ? mine : 1u; nx = cnt > 0u ? cnt : 1u;
}
__device__ __forceinline__ void xcd_barrier(const XcdBarrier& b) {
    asm volatile("s_waitcnt vmcnt(0)" ::: "memory");
    __syncthreads();
    if (threadIdx.x == 0) {
        unsigned* bar = b.bar;
        __builtin_amdgcn_s_waitcnt(0);
        unsigned nloc = b.st[0], nx = b.st[1];
        if (nloc == 0u) { xcd_barrier_complete(bar, b.x, nloc, nx); b.st[0] = nloc; b.st[1] = nx; }
        const unsigned old = xb_add(&bar[XB_XSUB(b.x)], 1u);
        const unsigned gen = old / nloc;
        if (old + 1u == (gen + 1u) * nloc) {
            __builtin_amdgcn_fence(__ATOMIC_RELEASE, "agent");
            asm volatile("s_waitcnt vmcnt(0)" ::: "memory");
            const unsigned og = xb_add(&bar[XB_TOP], 1u);
            const unsigned tg = og / nx;
            if (og + 1u == (tg + 1u) * nx) xb_add(&bar[XB_TOPGEN], 1u);
            else XB_SPIN(xb_ld(&bar[XB_TOPGEN]) == tg, bar);
            __builtin_amdgcn_fence(__ATOMIC_ACQUIRE, "agent");
            xb_add(&bar[XB_XGEN(b.x)], 1u);
            asm volatile("s_waitcnt vmcnt(0)" ::: "memory");
        } else {
            XB_SPIN(xb_ld(&bar[XB_XGEN(b.x)]) == gen, bar);
            __builtin_amdgcn_fence(__ATOMIC_ACQUIRE, "agent");
            asm volatile("s_waitcnt vmcnt(0)" ::: "memory");
        }
    }
    __syncthreads();
}

__device__ __forceinline__ void attn_simple(CParams P, int vcu, int G) {
    unsigned char* ws = P->ws; const float* relb = P->rel_bias;
    const bf16_t* Qh = (const bf16_t*)(ws + WS_QH); const bf16_t* Kh = (const bf16_t*)(ws + WS_KH); const bf16_t* Vh = (const bf16_t*)(ws + WS_VH);
    bf16_t* MIX = (bf16_t*)(ws + WS_MIX);
    const int lane = threadIdx.x & 63, wave = threadIdx.x >> 6;
    for (int task = vcu * NWAVES + wave; task < SEQ * NH; task += G * NWAVES) {
        const int t = task >> 4, h = task & 15;
        const int c = t >> 6, i = t & 63;
        const float qd = bf2f(Qh[((size_t)h * SEQ + t) * HD + lane]);
        float sc[9];
#pragma unroll
        for (int s = 0; s < 9; ++s) {
            const int ch = c - LEFT + s;
            float v = -1e30f;
            if (ch >= 0) {
                const int kpos = ch * 64 + lane;
                const bf16_t* kr = Kh + ((size_t)h * SEQ + kpos) * HD;
                float acc = 0.f;
                for (int d = 0; d < HD; d += 4) {
                    const v2u kv = *(const v2u*)(kr + d);
                    acc += __shfl(qd, d) * bf2f(kv.x & 0xffffu) + __shfl(qd, d + 1) * bf2f(kv.x >> 16) + __shfl(qd, d + 2) * bf2f(kv.y & 0xffffu) + __shfl(qd, d + 3) * bf2f(kv.y >> 16);
                }
                const int j = s * 64 + lane;
                int rel = LEFT * CHUNK + i - j; rel = rel < -RCLIP ? -RCLIP : (rel > RCLIP ? RCLIP : rel);
                v = acc + relb[h * NREL + rel + RCLIP] * LOG2E;
            }
            sc[s] = v;
        }
        float m = sc[0];
#pragma unroll
        for (int s = 1; s < 9; ++s) m = fmaxf(m, sc[s]);
        m = wave_max(m);
        float l = 0.f;
#pragma unroll
        for (int s = 0; s < 9; ++s) { const int ch = c - LEFT + s; sc[s] = (ch >= 0) ? exp2f(sc[s] - m) : 0.f; l += sc[s]; }
        l = wave_sum(l);
        float o = 0.f;
#pragma unroll
        for (int s = 0; s < 9; ++s) {
            const int ch = c - LEFT + s;
            if (ch >= 0) {
                const bf16_t* vr = Vh + ((size_t)h * SEQ + ch * 64) * HD + lane;
                for (int src = 0; src < 64; ++src) o += __shfl(sc[s], src) * bf2f(vr[(size_t)src * HD]);
            }
        }
        MIX[(size_t)t * DM + DCONV + h * HD + lane] = (bf16_t)f2bf(o / l);
    }
}
__device__ __forceinline__ void router_simple(CParams P, int vcu, int G, LAS unsigned char* lds) {
    unsigned char* ws = P->ws; const float* bg = P->b_group; const float* be = P->b_er;
    const bf16_t* X1G = (const bf16_t*)(ws + WS_X1G); const float* SSP = (const float*)(ws + WS_SSP); const bf16_t* WrT = (const bf16_t*)(ws + WS_WRT);
    float* RSTD2 = (float*)(ws + WS_RSTD2); int* cnt = (int*)(ws + WS_CTL + CTL_CNT); int* ltk = (int*)(ws + WS_LTK); float* lgt = (float*)(ws + WS_LGT);
    const int lane = threadIdx.x & 63, wave = threadIdx.x >> 6;
    LAS float* hs = (LAS float*)(lds + wave * 8192);
    __syncthreads();
    for (int t = vcu * NWAVES + wave; t < SEQ; t += G * NWAVES) {
        float ss = 0.f;
        for (int i = 0; i < 32; ++i) ss += SSP[(size_t)i * SEQ + t];
        const float rstd = rsqrtf(ss * (1.f / DM) + 1e-6f);
        if (lane == 0) RSTD2[t] = rstd;
        asm volatile("s_waitcnt lgkmcnt(0)" ::: "memory");
        for (int i = 0; i < 32; ++i) { const int k = lane + 64 * i; hs[k] = bf2f(X1G[(size_t)t * DM + k]); }
        asm volatile("s_waitcnt lgkmcnt(0)" ::: "memory");
        float ae = 0.f, ag = 0.f;
        for (int k = 0; k < DM; ++k) { const float hv = hs[k]; ae += hv * bf2f(WrT[(size_t)(NG + lane) * DM + k]); ag += hv * bf2f(WrT[(size_t)(lane & 7) * DM + k]); }
        const float el = ae * rstd + be[lane], gl = ag * rstd + bg[lane & 7];
        float gmax = -INFINITY; int grp = 0;
        for (int g = 0; g < NG; ++g) { const float v = __shfl(gl, g); if (v > gmax) { gmax = v; grp = g; } }
        float sum = 0.f;
        for (int g = 0; g < NG; ++g) sum += __expf(__shfl(gl, g) - gmax);
        const float pgrp = 1.f / sum;
        float v0 = -INFINITY, v1 = -INFINITY; int i0 = 0, i1 = 0;
        for (int i = 0; i < EPG; ++i) {
            const float v = __shfl(el, grp * EPG + i);
            if (v > v0) { v1 = v0; i1 = i0; v0 = v; i0 = i; } else if (v > v1) { v1 = v; i1 = i; }
        }
        const float e1 = __expf(v1 - v0), inv = 1.f / (1.f + e1);
        if (lane == 0) {
            const int ea = grp * EPG + i0, eb = grp * EPG + i1;
            const int sa = atomicAdd(&cnt[ea], 1); ltk[ea * LCAP + sa] = t * 2 + 0; lgt[ea * LCAP + sa] = inv * pgrp;
            const int sb = atomicAdd(&cnt[eb], 1); ltk[eb * LCAP + sb] = t * 2 + 1; lgt[eb * LCAP + sb] = e1 * inv * pgrp;
        }
    }
}

typedef short v4i16_t __attribute__((ext_vector_type(4)));
constexpr int ATT_BUF = 16384, ATT_V = 8192, ATT_BIAS = 32768;
__device__ __forceinline__ int crow(int r, int hi) { return (r & 3) + 8 * (r >> 2) + 4 * hi; }
__device__ __forceinline__ void attn_unit(CParams P, int h, int cg, LAS unsigned char* lds) {
    const int tid = threadIdx.x, lane = tid & 63, wave = __builtin_amdgcn_readfirstlane(tid >> 6), r32 = lane & 31, hi = lane >> 5;
    unsigned char* ws = P->ws;
    const bf16_t* Qh = (const bf16_t*)(ws + WS_QH) + (size_t)h * SEQ * HD; const bf16_t* Kh = (const bf16_t*)(ws + WS_KH) + (size_t)h * SEQ * HD;
    const bf16_t* Vh = (const bf16_t*)(ws + WS_VH) + (size_t)h * SEQ * HD; bf16_t* MIX = (bf16_t*)(ws + WS_MIX);
    const int c = cg * 8 + wave;
    LAS float* bias = (LAS float*)(lds + ATT_BIAS);
    __syncthreads();
    for (int i = tid; i < NREL; i += NTHR) bias[i] = P->rel_bias[h * NREL + i] * LOG2E;
    bf16x8 qf[2][4];
#pragma unroll
    for (int qb = 0; qb < 2; ++qb)
#pragma unroll
        for (int s = 0; s < 4; ++s) qf[qb][s] = *(const bf16x8*)(Qh + (size_t)(c * 64 + qb * 32 + r32) * HD + s * 16 + hi * 8);
    float mrun[2] = {-1e30f, -1e30f}, lrun[2] = {0.f, 0.f};
    f32x16 O[2][2];
#pragma unroll
    for (int a = 0; a < 2; ++a)
#pragma unroll
        for (int b = 0; b < 2; ++b)
#pragma unroll
            for (int r = 0; r < 16; ++r) O[a][b][r] = 0.f;
    const int kt0 = cg * 8 - 8 < 0 ? 0 : cg * 8 - 8, kt1 = cg * 8 + 7;
    const int skey = tid >> 3, sch = tid & 7;
    const bf16_t* Kg = Kh + (size_t)skey * HD + sch * 8; const bf16_t* Vg = Vh + (size_t)skey * HD + sch * 8;
    const int kwoff = skey * 128 + ((sch ^ (skey & 7)) << 4), vwoff = ATT_V + skey * 128 + (sch << 4);
    v4u kreg = *(const v4u*)(Kg + (size_t)kt0 * 64 * HD), vreg = *(const v4u*)(Vg + (size_t)kt0 * 64 * HD);
    *(LAS v4u*)(lds + kwoff) = kreg; *(LAS v4u*)(lds + vwoff) = vreg;
    __syncthreads();
    const int kroff = r32 * 128;
    const int vq = (lane & 15) >> 2, vp = lane & 3, vg1 = (lane >> 4) & 1;
    const int vroff = ATT_V + (4 * hi + vq) * 128 + (16 * vg1 + 4 * vp) * 2;
    for (int kt = kt0; kt <= kt1; ++kt) {
        const int cur = (kt - kt0) & 1;
        if (kt < kt1) { kreg = *(const v4u*)(Kg + (size_t)(kt + 1) * 64 * HD); vreg = *(const v4u*)(Vg + (size_t)(kt + 1) * 64 * HD); }
        if (kt >= c - 8 && kt <= c) {
            const int tt = kt - (c - 8);
            LAS unsigned char* buf = lds + cur * ATT_BUF;
            bf16x8 kf[2][4];
#pragma unroll
            for (int kh = 0; kh < 2; ++kh)
#pragma unroll
                for (int s = 0; s < 4; ++s) kf[kh][s] = *(const LAS bf16x8*)(buf + kh * 4096 + kroff + (((2 * s + hi) ^ (r32 & 7)) << 4));
            bf16x8 pb[2][2][2];
#pragma unroll
            for (int qb = 0; qb < 2; ++qb) {
                f32x16 S0, S1;
#pragma unroll
                for (int r = 0; r < 16; ++r) { S0[r] = 0.f; S1[r] = 0.f; }
#pragma unroll
                for (int s = 0; s < 4; ++s) { S0 = __builtin_amdgcn_mfma_f32_32x32x16_bf16(kf[0][s], qf[qb][s], S0, 0, 0, 0); S1 = __builtin_amdgcn_mfma_f32_32x32x16_bf16(kf[1][s], qf[qb][s], S1, 0, 0, 0); }
                if (tt <= 5) { const float b = bias[2 * RCLIP];
#pragma unroll
                    for (int r = 0; r < 16; ++r) { S0[r] += b; S1[r] += b; } }
                else { const int base = LEFT * CHUNK - 64 * tt + qb * 32 + r32;
#pragma unroll
                    for (int r = 0; r < 16; ++r) { int d0 = base - crow(r, hi), d1 = d0 - 32;
                        d0 = d0 > RCLIP ? RCLIP : (d0 < -RCLIP ? -RCLIP : d0); d1 = d1 > RCLIP ? RCLIP : (d1 < -RCLIP ? -RCLIP : d1);
                        S0[r] += bias[d0 + RCLIP]; S1[r] += bias[d1 + RCLIP]; } }
                float mx = fmaxf(S0[0], S1[0]);
#pragma unroll
                for (int r = 1; r < 16; ++r) mx = fmaxf(mx, fmaxf(S0[r], S1[r]));
                mx = fmaxf(mx, __shfl_xor(mx, 32));
                const float mnew = fmaxf(mrun[qb], mx), alpha = exp2f(mrun[qb] - mnew);
                mrun[qb] = mnew;
                float rs = 0.f;
#pragma unroll
                for (int r = 0; r < 16; ++r) { S0[r] = exp2f(S0[r] - mnew); S1[r] = exp2f(S1[r] - mnew); rs += S0[r] + S1[r]; }
                rs += __shfl_xor(rs, 32);
                lrun[qb] = lrun[qb] * alpha + rs;
#pragma unroll
                for (int r = 0; r < 16; ++r) { O[qb][0][r] *= alpha; O[qb][1][r] *= alpha; }
#pragma unroll
                for (int s2 = 0; s2 < 2; ++s2) {
                    v4u w0, w1;
                    w0.x = g8::cvt_pk_bf16(S0[8 * s2 + 0], S0[8 * s2 + 1]); w0.y = g8::cvt_pk_bf16(S0[8 * s2 + 2], S0[8 * s2 + 3]); w0.z = g8::cvt_pk_bf16(S0[8 * s2 + 4], S0[8 * s2 + 5]); w0.w = g8::cvt_pk_bf16(S0[8 * s2 + 6], S0[8 * s2 + 7]);
                    w1.x = g8::cvt_pk_bf16(S1[8 * s2 + 0], S1[8 * s2 + 1]); w1.y = g8::cvt_pk_bf16(S1[8 * s2 + 2], S1[8 * s2 + 3]); w1.z = g8::cvt_pk_bf16(S1[8 * s2 + 4], S1[8 * s2 + 5]); w1.w = g8::cvt_pk_bf16(S1[8 * s2 + 6], S1[8 * s2 + 7]);
                    pb[qb][0][s2] = __builtin_bit_cast(bf16x8, w0); pb[qb][1][s2] = __builtin_bit_cast(bf16x8, w1);
                }
            }
#pragma unroll
            for (int dh = 0; dh < 2; ++dh)
#pragma unroll
                for (int kh = 0; kh < 2; ++kh)
#pragma unroll
                    for (int s2 = 0; s2 < 2; ++s2) {
                        const LAS unsigned char* vp0 = buf + vroff + (32 * kh + 16 * s2) * 128 + 64 * dh;
                        const v4i16_t lo = __builtin_amdgcn_ds_read_tr16_b64_v4i16((LAS v4i16_t*)vp0);
                        const v4i16_t hv = __builtin_amdgcn_ds_read_tr16_b64_v4i16((LAS v4i16_t*)(vp0 + 8 * 128));
                        const bf16x8 vf = (bf16x8){lo[0], lo[1], lo[2], lo[3], hv[0], hv[1], hv[2], hv[3]};
                        O[0][dh] = __builtin_amdgcn_mfma_f32_32x32x16_bf16(vf, pb[0][kh][s2], O[0][dh], 0, 0, 0);
                        O[1][dh] = __builtin_amdgcn_mfma_f32_32x32x16_bf16(vf, pb[1][kh][s2], O[1][dh], 0, 0, 0);
                    }
        }
        if (kt < kt1) { LAS unsigned char* nb = lds + (cur ^ 1) * ATT_BUF; *(LAS v4u*)(nb + kwoff) = kreg; *(LAS v4u*)(nb + vwoff) = vreg; }
        __syncthreads();
    }
#pragma unroll
    for (int qb = 0; qb < 2; ++qb) {
        const float inv = 1.f / lrun[qb];
        bf16_t* orow = MIX + (size_t)(c * 64 + qb * 32 + r32) * DM + DCONV + h * HD + 4 * hi;
#pragma unroll
        for (int dh = 0; dh < 2; ++dh)
#pragma unroll
            for (int g = 0; g < 4; ++g) {
                v2u w; w.x = g8::cvt_pk_bf16(O[qb][dh][4 * g] * inv, O[qb][dh][4 * g + 1] * inv); w.y = g8::cvt_pk_bf16(O[qb][dh][4 * g + 2] * inv, O[qb][dh][4 * g + 3] * inv);
                *(v2u*)(orow + dh * 32 + 8 * g) = w;
            }
    }
}

constexpr int RT_RED = 0, RT_LOG = 8 * 32 * NRT * 4, RT_RS = RT_LOG + 32 * NRT * 4;
__device__ __forceinline__ void router_item(CParams P, int item, LAS unsigned char* lds) {
    const int tid = threadIdx.x, lane = tid & 63, wave = __builtin_amdgcn_readfirstlane(tid >> 6), fr = lane & 15, fq = lane >> 4;
    unsigned char* ws = P->ws;
    const bf16_t* X1G = (const bf16_t*)(ws + WS_X1G); const float* SSP = (const float*)(ws + WS_SSP); const bf16_t* WrT = (const bf16_t*)(ws + WS_WRT);
    float* RSTD2 = (float*)(ws + WS_RSTD2); int* cnt = (int*)(ws + WS_CTL + CTL_CNT); int* ltk = (int*)(ws + WS_LTK); float* lgt = (float*)(ws + WS_LGT);
    const int row0 = item * 32;
    LAS float* red = (LAS float*)(lds + RT_RED); LAS float* lg = (LAS float*)(lds + RT_LOG); LAS float* rsl = (LAS float*)(lds + RT_RS);
    f32x4 acc[2][5];
#pragma unroll
    for (int rb = 0; rb < 2; ++rb)
#pragma unroll
        for (int cb = 0; cb < 5; ++cb) acc[rb][cb] = (f32x4){0.f, 0.f, 0.f, 0.f};
    const bf16_t* ap = X1G + (size_t)(row0 + fr) * DM + wave * 256 + fq * 8;
    const bf16_t* bp = WrT + (size_t)fr * DM + wave * 256 + fq * 8;
#pragma unroll 2
    for (int ks = 0; ks < 8; ++ks) {
        bf16x8 a[2], b[5];
#pragma unroll
        for (int rb = 0; rb < 2; ++rb) a[rb] = *(const bf16x8*)(ap + (size_t)rb * 16 * DM + ks * 32);
#pragma unroll
        for (int cb = 0; cb < 5; ++cb) b[cb] = *(const bf16x8*)(bp + (size_t)cb * 16 * DM + ks * 32);
#pragma unroll
        for (int rb = 0; rb < 2; ++rb)
#pragma unroll
            for (int cb = 0; cb < 5; ++cb) acc[rb][cb] = __builtin_amdgcn_mfma_f32_16x16x32_bf16(a[rb], b[cb], acc[rb][cb], 0, 0, 0);
    }
    __syncthreads();
#pragma unroll
    for (int rb = 0; rb < 2; ++rb)
#pragma unroll
        for (int cb = 0; cb < 5; ++cb)
#pragma unroll
            for (int i = 0; i < 4; ++i) red[(wave * 32 + rb * 16 + 4 * fq + i) * NRT + cb * 16 + fr] = acc[rb][cb][i];
    if (tid < 32) {
        float ss = 0.f;
        for (int i = 0; i < 32; ++i) ss += SSP[(size_t)i * SEQ + row0 + tid];
        const float rstd = rsqrtf(ss * (1.f / DM) + 1e-6f);
        RSTD2[row0 + tid] = rstd; rsl[tid] = rstd;
    }
    __syncthreads();
    for (int idx = tid; idx < 32 * NRT; idx += NTHR) {
        float s = 0.f;
#pragma unroll
        for (int w = 0; w < NWAVES; ++w) s += red[w * 32 * NRT + idx];
        lg[idx] = s;
    }
    __syncthreads();
    if (tid < 32) {
        const int t = row0 + tid; const float rstd = rsl[tid]; const LAS float* L = lg + tid * NRT;
        const float* bg = P->b_group; const float* be = P->b_er;
        float gmax = -INFINITY; int grp = 0; float glv[NG];
#pragma unroll
        for (int g = 0; g < NG; ++g) { glv[g] = L[g] * rstd + bg[g]; if (glv[g] > gmax) { gmax = glv[g]; grp = g; } }
        float sum = 0.f;
#pragma unroll
        for (int g = 0; g < NG; ++g) sum += __expf(glv[g] - gmax);
        const float pgrp = 1.f / sum;
        float v0 = -INFINITY, v1 = -INFINITY; int i0 = 0, i1 = 0;
        for (int i = 0; i < EPG; ++i) {
            const float v = L[NG + grp * EPG + i] * rstd + be[grp * EPG + i];
            if (v > v0) { v1 = v0; i1 = i0; v0 = v; i0 = i; } else if (v > v1) { v1 = v; i1 = i; }
        }
        const float e1 = __expf(v1 - v0), inv = 1.f / (1.f + e1);
        const int ea = grp * EPG + i0, eb = grp * EPG + i1;
        const int sa = atomicAdd(&cnt[ea], 1); ltk[ea * LCAP + sa] = t * 2 + 0; lgt[ea * LCAP + sa] = inv * pgrp;
        const int sb = atomicAdd(&cnt[eb], 1); ltk[eb * LCAP + sb] = t * 2 + 1; lgt[eb * LCAP + sb] = e1 * inv * pgrp;
    }
}

constexpr int LDS_TAB = 131072;
constexpr int LDS_MISC = 131072 + 4096;
__device__ __forceinline__ void moe_build_table(CParams P, LAS unsigned char* lds) {
    LAS int* tab = (LAS int*)(lds + LDS_TAB);
    __syncthreads();
    if (threadIdx.x == 0) {
        int* cnt = (int*)(P->ws + WS_CTL + CTL_CNT);
        int ts = 0, os = 0;
        for (int e = 0; e < NE; ++e) { const int c = __hip_atomic_load(cnt + e, __ATOMIC_RELAXED, __HIP_MEMORY_SCOPE_AGENT); tab[g8::TAB_TS + e] = ts; tab[g8::TAB_OS + e] = os; tab[g8::TAB_CN + e] = c; ts += (c + 255) >> 8; os += c; }
        tab[g8::TAB_TS + NE] = ts; tab[g8::TAB_OS + NE] = os;
    }
    __syncthreads();
}
constexpr int LDS_BYTES = 147456;
__global__ void __launch_bounds__(NTHR, 2) mega(Params p_kernarg) {
    extern __shared__ __attribute__((aligned(16))) unsigned char lds_raw[];
    LAS unsigned char* lds = (LAS unsigned char*)lds_raw;
    const int G = gridDim.x, bx = blockIdx.x;
    const int vcu = (G % 8 == 0) ? (bx % 8) * (G / 8) + bx / 8 : bx;
    CParams P = kparams();
    const int lo = P->ph_lo, hi = P->ph_hi;
#define IN(k) (lo <= (k) && (k) < hi)
#define BOTH(k) (IN(k) && IN((k) + 1))
    volatile LAS unsigned* misc = (volatile LAS unsigned*)(lds + LDS_MISC);
    if (threadIdx.x < 32) misc[threadIdx.x] = 0u;
    __syncthreads();
    XcdBarrier bar; bar.bar = (unsigned*)(P->ws + WS_CTL) + P->li * XCD_BAR_WORDS; bar.x = 0; bar.st = misc + 8;
    if (hi - lo > 1) bar = xcd_barrier_post(bar.bar, misc + 8);
#define GRID_BAR(k) do { if (BOTH(k)) xcd_barrier(bar); } while (0)
    if (IN(0)) { phase_prologue(kparams(), vcu, G, lds); GRID_BAR(0); }
#if FAST_GEMM1
    if (IN(1)) {
        g8::DenseOrder S; S.init(P->ws + WS_HB, P->ws + WS_WINT, SEQ, DIN, DM, G, bx);
        g8::EpiIn E{P};
        g8::gemm_phase<g8::EpiIn, g8::DenseOrder, false>(lds, DM, (size_t)g8::HALF * DM * 2, (size_t)g8::HALF * DM * 2, S, E);
        GRID_BAR(1);
    }
#endif
    if (IN(2)) {
#if !FAST_ATTN
        attn_simple(kparams(), vcu, G);
#else
        for (int u = vcu; u < NH * (SEQ / 512); u += G) attn_unit(kparams(), u >> 4, u & 15, lds);
#endif
        for (int it = vcu; it < SEQ / CONV_T; it += G) conv_item(kparams(), it, lds);
        GRID_BAR(2);
    }
#if FAST_GEMM2
    if (IN(3)) {
        g8::DenseOrder S; S.init(P->ws + WS_MIX, P->ws + WS_WOUTT, SEQ, DM, DM, G, bx);
        g8::EpiOut E{P};
        g8::gemm_phase<g8::EpiOut, g8::DenseOrder, false>(lds, DM, (size_t)g8::HALF * DM * 2, (size_t)g8::HALF * DM * 2, S, E);
        GRID_BAR(3);
    }
#endif
    if (IN(4)) {
#if !FAST_ROUTER
        router_simple(kparams(), vcu, G, lds);
#else
        for (int it = vcu; it < SEQ / 32; it += G) router_item(kparams(), it, lds);
#endif
        GRID_BAR(4);
    }
#if FAST_MOE
    if (IN(5)) {
        moe_build_table(kparams(), lds);
        const LAS int* tab = (const LAS int*)(lds + LDS_TAB);
        g8::MoeOrder<4, false> S{tab, G, vcu, (const char*)P->ws};
        g8::EpiUp E{tab, P};
        g8::gemm_phase<g8::EpiUp, g8::MoeOrder<4, false>, true>(lds, DM, (size_t)0, (size_t)(WS_WUT - WS_WGT), S, E);
        GRID_BAR(5);
    }
    if (IN(6)) {
        moe_build_table(kparams(), lds);
        const LAS int* tab = (const LAS int*)(lds + LDS_TAB);
        g8::MoeOrder<8, true> S{tab, G, vcu, (const char*)P->ws};
        g8::EpiDown E{tab, P};
        g8::gemm_phase<g8::EpiDown, g8::MoeOrder<8, true>, false>(lds, DE, (size_t)g8::HALF * DE * 2, (size_t)g8::HALF * DE * 2, S, E);
        GRID_BAR(6);
    }
#endif
    if (IN(7)) phase_final(kparams(), vcu, G);
#undef IN
#undef BOTH
#undef GRID_BAR
}

template <class AL, class BL, class EP>
__device__ __forceinline__ void gemm64_f32(int K, AL aload, BL bload, EP epi) {
    __shared__ float As[16][68];
    __shared__ float Bs[16][64];
    const int tid = threadIdx.x, ty = tid >> 4, tx = tid & 15;
    float acc[4][4];
#pragma unroll
    for (int i = 0; i < 4; ++i)
#pragma unroll
        for (int j = 0; j < 4; ++j) acc[i][j] = 0.f;
    const int am = tid >> 2, ak = (tid & 3) * 4;
    const int bk = tid >> 4, bn = (tid & 15) * 4;
    for (int k0 = 0; k0 < K; k0 += 16) {
        const float4 a = aload(am, k0 + ak);
        const float4 b = bload(k0 + bk, bn);
        __syncthreads();
        As[ak + 0][am] = a.x; As[ak + 1][am] = a.y; As[ak + 2][am] = a.z; As[ak + 3][am] = a.w;
        *(float4*)&Bs[bk][bn] = b;
        __syncthreads();
#pragma unroll
        for (int kk = 0; kk < 16; ++kk) {
            const float4 av = *(const float4*)&As[kk][ty * 4];
            const float4 bv = *(const float4*)&Bs[kk][tx * 4];
            const float aa[4] = {av.x, av.y, av.z, av.w};
            const float bb[4] = {bv.x, bv.y, bv.z, bv.w};
#pragma unroll
            for (int i = 0; i < 4; ++i)
#pragma unroll
                for (int j = 0; j < 4; ++j) acc[i][j] += aa[i] * bb[j];
        }
    }
#pragma unroll
    for (int i = 0; i < 4; ++i) epi(ty * 4 + i, tx * 4, make_float4(acc[i][0], acc[i][1], acc[i][2], acc[i][3]));
}
__device__ __forceinline__ float4 ld4bf(const bf16_t* p) { const v2u v = *(const v2u*)p; return make_float4(bf2f(v.x & 0xffffu), bf2f(v.x >> 16), bf2f(v.y & 0xffffu), bf2f(v.y >> 16)); }
__device__ __forceinline__ float4 ld4bt(const bf16_t* BT, int ldk, int n, int k) {
    return make_float4(bf2f(BT[(size_t)n * ldk + k]), bf2f(BT[(size_t)(n + 1) * ldk + k]), bf2f(BT[(size_t)(n + 2) * ldk + k]), bf2f(BT[(size_t)(n + 3) * ldk + k]));
}

__global__ void __launch_bounds__(256) n_gemm1(unsigned char* ws) {
    const bf16_t* Hb = (const bf16_t*)(ws + WS_HB); const bf16_t* WinT = (const bf16_t*)(ws + WS_WINT);
    float* VG = (float*)(ws + WS_VG); bf16_t* QKV = (bf16_t*)(ws + WS_QH);
    const int n0 = blockIdx.x * 64, m0 = blockIdx.y * 64;
    gemm64_f32(DM,
        [&](int m, int k) { return ld4bf(Hb + (size_t)(m0 + m) * DM + k); },
        [&](int k, int n) { return ld4bt(WinT, DM, n0 + n, k); },
        [&](int m, int n, float4 v) {
            const int c = n0 + n, row = m0 + m;
            if (c < 2048) { *(float4*)&VG[(size_t)row * 2048 + c] = v; }
            else { const int cq = c - 2048, which = cq >> 10, head = (cq & 1023) >> 6, d = cq & 63; const float sc = which == 0 ? QSCALE : 1.f;
                v2u o; o.x = pk2(v.x * sc, v.y * sc); o.y = pk2(v.z * sc, v.w * sc);
                *(v2u*)(QKV + (size_t)which * (NH * SEQ * HD) + ((size_t)head * SEQ + row) * HD + d) = o; } });
}
__global__ void __launch_bounds__(256) n_glu(unsigned char* ws) {
    const float* VG = (const float*)(ws + WS_VG); bf16_t* U = (bf16_t*)(ws + WS_U);
    const int idx = blockIdx.x * 256 + threadIdx.x; const int row = idx >> 10, c = idx & 1023;
    const int r0 = 256 * (c >> 7) + (c & 127);
    const float a = VG[(size_t)row * 2048 + r0], g = VG[(size_t)row * 2048 + r0 + 128];
    U[idx] = (bf16_t)f2bf(a * sigmoidf_(g));
}
__global__ void __launch_bounds__(256) n_attn(unsigned char* ws, const float* __restrict__ relb) {
    const bf16_t* Qh = (const bf16_t*)(ws + WS_QH); const bf16_t* Kh = (const bf16_t*)(ws + WS_KH); const bf16_t* Vh = (const bf16_t*)(ws + WS_VH);
    bf16_t* MIX = (bf16_t*)(ws + WS_MIX);
    const int t = blockIdx.x, h = blockIdx.y * 4 + (threadIdx.x >> 6), lane = threadIdx.x & 63;
    const int c = t >> 6, i = t & 63;
    const float qd = bf2f(Qh[((size_t)h * SEQ + t) * HD + lane]);
    float sc[9];
#pragma unroll
    for (int s = 0; s < 9; ++s) {
        const int ch = c - LEFT + s;
        float v = -1e30f;
        if (ch >= 0) {
            const int kpos = ch * 64 + lane;
            const bf16_t* kr = Kh + ((size_t)h * SEQ + kpos) * HD;
            float acc = 0.f;
            for (int d = 0; d < HD; d += 4) {
                const float4 kk = ld4bf(kr + d);
                acc += __shfl(qd, d) * kk.x + __shfl(qd, d + 1) * kk.y + __shfl(qd, d + 2) * kk.z + __shfl(qd, d + 3) * kk.w;
            }
            const int j = s * 64 + lane;
            int rel = LEFT * CHUNK + i - j; rel = rel < -RCLIP ? -RCLIP : (rel > RCLIP ? RCLIP : rel);
            v = acc + relb[h * NREL + rel + RCLIP] * LOG2E;
        }
        sc[s] = v;
    }
    float m = sc[0];
#pragma unroll
    for (int s = 1; s < 9; ++s) m = fmaxf(m, sc[s]);
    m = wave_max(m);
    float l = 0.f;
#pragma unroll
    for (int s = 0; s < 9; ++s) { const int ch = c - LEFT + s; sc[s] = (ch >= 0) ? exp2f(sc[s] - m) : 0.f; l += sc[s]; }
    l = wave_sum(l);
    float o = 0.f;
#pragma unroll
    for (int s = 0; s < 9; ++s) {
        const int ch = c - LEFT + s;
        if (ch >= 0) {
            const bf16_t* vr = Vh + ((size_t)h * SEQ + ch * 64) * HD + lane;
            for (int src = 0; src < 64; ++src) o += __shfl(sc[s], src) * bf2f(vr[(size_t)src * HD]);
        }
    }
    MIX[(size_t)t * DM + DCONV + h * HD + lane] = (bf16_t)f2bf(o / l);
}
__global__ void __launch_bounds__(256) n_gemm2(unsigned char* ws, const float* __restrict__ x, const float* __restrict__ g2) {
    const bf16_t* MIX = (const bf16_t*)(ws + WS_MIX); const bf16_t* WoutT = (const bf16_t*)(ws + WS_WOUTT);
    float* X1 = (float*)(ws + WS_X1); bf16_t* X1G = (bf16_t*)(ws + WS_X1G); float* SSP = (float*)(ws + WS_SSP);
    const int n0 = blockIdx.x * 64, m0 = blockIdx.y * 64;
    gemm64_f32(DM,
        [&](int m, int k) { return ld4bf(MIX + (size_t)(m0 + m) * DM + k); },
        [&](int k, int n) { return ld4bt(WoutT, DM, n0 + n, k); },
        [&](int m, int n, float4 v) {
            const size_t o = (size_t)(m0 + m) * DM + n0 + n; const float4 r = *(const float4*)&x[o]; const float4 g = *(const float4*)&g2[n0 + n];
            const float4 s = make_float4(r.x + v.x, r.y + v.y, r.z + v.z, r.w + v.w);
            *(float4*)&X1[o] = s;
            v2u pk; pk.x = pk2(s.x * g.x, s.y * g.y); pk.y = pk2(s.z * g.z, s.w * g.w); *(v2u*)(X1G + o) = pk;
            float q = s.x * s.x + s.y * s.y + s.z * s.z + s.w * s.w;
            q += __shfl_xor(q, 1); q += __shfl_xor(q, 2); q += __shfl_xor(q, 4); q += __shfl_xor(q, 8);
            if ((threadIdx.x & 15) == 0) SSP[(size_t)blockIdx.x * SEQ + m0 + m] = q; });
}
__global__ void __launch_bounds__(64) n_router(unsigned char* ws, const float* __restrict__ bg, const float* __restrict__ be) {
    __shared__ float hs[DM];
    const bf16_t* X1G = (const bf16_t*)(ws + WS_X1G); const float* SSP = (const float*)(ws + WS_SSP); const bf16_t* WrT = (const bf16_t*)(ws + WS_WRT);
    float* RSTD2 = (float*)(ws + WS_RSTD2); int* cnt = (int*)(ws + WS_CTL + CTL_CNT); int* ltk = (int*)(ws + WS_LTK); float* lgt = (float*)(ws + WS_LGT);
    const int t = blockIdx.x, lane = threadIdx.x;
    float ss = 0.f;
    for (int i = 0; i < 32; ++i) ss += SSP[(size_t)i * SEQ + t];
    const float rstd = rsqrtf(ss * (1.f / DM) + 1e-6f);
    if (lane == 0) RSTD2[t] = rstd;
    for (int i = 0; i < 32; ++i) { const int k = lane + 64 * i; hs[k] = bf2f(X1G[(size_t)t * DM + k]); }
    __syncthreads();
    float ae = 0.f, ag = 0.f;
    for (int k = 0; k < DM; ++k) { const float hv = hs[k]; ae += hv * bf2f(WrT[(size_t)(NG + lane) * DM + k]); ag += hv * bf2f(WrT[(size_t)(lane & 7) * DM + k]); }
    const float el = ae * rstd + be[lane], gl = ag * rstd + bg[lane & 7];
    float gmax = -INFINITY; int grp = 0;
    for (int g = 0; g < NG; ++g) { const float v = __shfl(gl, g); if (v > gmax) { gmax = v; grp = g; } }
    float sum = 0.f;
    for (int g = 0; g < NG; ++g) sum += __expf(__shfl(gl, g) - gmax);
    const float pgrp = 1.f / sum;
    float v0 = -INFINITY, v1 = -INFINITY; int i0 = 0, i1 = 0;
    for (int i = 0; i < EPG; ++i) {
        const float v = __shfl(el, grp * EPG + i);
        if (v > v0) { v1 = v0; i1 = i0; v0 = v; i0 = i; } else if (v > v1) { v1 = v; i1 = i; }
    }
    const float e1 = __expf(v1 - v0), inv = 1.f / (1.f + e1);
    if (lane == 0) {
        const int ea = grp * EPG + i0, eb = grp * EPG + i1;
        const int sa = atomicAdd(&cnt[ea], 1); ltk[ea * LCAP + sa] = t * 2 + 0; lgt[ea * LCAP + sa] = inv * pgrp;
        const int sb = atomicAdd(&cnt[eb], 1); ltk[eb * LCAP + sb] = t * 2 + 1; lgt[eb * LCAP + sb] = e1 * inv * pgrp;
    }
}
__global__ void __launch_bounds__(256) n_moe_up(unsigned char* ws) {
    const bf16_t* X1G = (const bf16_t*)(ws + WS_X1G); const float* RSTD2 = (const float*)(ws + WS_RSTD2);
    const int* cnt = (const int*)(ws + WS_CTL + CTL_CNT); const int* ltk = (const int*)(ws + WS_LTK);
    float* VG = (float*)(ws + WS_VG); bf16_t* HM = (bf16_t*)(ws + WS_HM);
    const int e = blockIdx.z, mt = blockIdx.y, nt = blockIdx.x;
    const int ce = cnt[e];
    if (mt * 64 >= ce) return;
    int ob = 0; for (int i = 0; i < e; ++i) ob += cnt[i];
    const int am = threadIdx.x >> 2; const int idx = mt * 64 + am;
    const int tok = idx < ce ? (ltk[e * LCAP + idx] >> 1) : -1;
    const bf16_t* WT = (const bf16_t*)(ws + (nt < 8 ? WS_WGT : WS_WUT)) + (size_t)e * DE * DM + (size_t)((nt & 7) * 64) * DM;
    gemm64_f32(DM,
        [&](int m, int k) { return tok >= 0 ? ld4bf(X1G + (size_t)tok * DM + k) : make_float4(0.f, 0.f, 0.f, 0.f); },
        [&](int k, int n) { return ld4bt(WT, DM, n, k); },
        [&](int m, int n, float4 v) { const int id = mt * 64 + m; if (id < ce) { const float rs = RSTD2[ltk[e * LCAP + id] >> 1];
            *(float4*)&VG[(size_t)(ob + id) * 1024 + nt * 64 + n] = make_float4(v.x * rs, v.y * rs, v.z * rs, v.w * rs); } });
    (void)HM;
}
__global__ void __launch_bounds__(256) n_moe_act(unsigned char* ws) {
    const float* VG = (const float*)(ws + WS_VG); bf16_t* HM = (bf16_t*)(ws + WS_HM);
    const int idx = blockIdx.x * 256 + threadIdx.x; const int row = idx >> 9, c = idx & 511;
    const float g = VG[(size_t)row * 1024 + c], u = VG[(size_t)row * 1024 + 512 + c];
    HM[idx] = (bf16_t)f2bf(g * sigmoidf_(g) * u);
}
__global__ void __launch_bounds__(256) n_moe_down(unsigned char* ws) {
    const bf16_t* HM = (const bf16_t*)(ws + WS_HM); const bf16_t* WdT = (const bf16_t*)(ws + WS_WDT);
    const int* cnt = (const int*)(ws + WS_CTL + CTL_CNT); const int* ltk = (const int*)(ws + WS_LTK); const float* lgt = (const float*)(ws + WS_LGT);
    bf16_t* Y = (bf16_t*)(ws + WS_Y);
    const int e = blockIdx.z, mt = blockIdx.y, nt = blockIdx.x;
    const int ce = cnt[e];
    if (mt * 64 >= ce) return;
    int ob = 0; for (int i = 0; i < e; ++i) ob += cnt[i];
    const int am = threadIdx.x >> 2; const int idx = mt * 64 + am;
    const bf16_t* WT = WdT + (size_t)e * DM * DE + (size_t)(nt * 64) * DE;
    gemm64_f32(DE,
        [&](int m, int k) { return idx < ce ? ld4bf(HM + (size_t)(ob + idx) * DE + k) : make_float4(0.f, 0.f, 0.f, 0.f); },
        [&](int k, int n) { return ld4bt(WT, DE, n, k); },
        [&](int m, int n, float4 v) {
            const int id = mt * 64 + m;
            if (id < ce) { const int tk = ltk[e * LCAP + id]; const float gt = lgt[e * LCAP + id];
                v2u o; o.x = pk2(gt * v.x, gt * v.y); o.y = pk2(gt * v.z, gt * v.w);
                *(v2u*)(Y + (size_t)tk * DM + nt * 64 + n) = o; } });
}

extern "C" void kernel_launch(void* const* d_in, const int* in_sizes, int n_in, void* d_out, int out_size, void* d_ws, size_t ws_size, hipStream_t stream) {
    static int grid = 0;
    if (grid == 0) {
        if (ws_size < WS_END) { fprintf(stderr, "kernel_launch: workspace too small (%zu < %zu)\n", ws_size, (size_t)WS_END); grid = -1; return; }
        int dev = 0, cus = 0, per_cu = 0;
        (void)hipGetDevice(&dev); (void)hipDeviceGetAttribute(&cus, hipDeviceAttributeMultiprocessorCount, dev);
        (void)hipFuncSetAttribute((const void*)mega, hipFuncAttributeMaxDynamicSharedMemorySize, LDS_BYTES);
        (void)hipOccupancyMaxActiveBlocksPerMultiprocessor(&per_cu, (const void*)mega, NTHR, LDS_BYTES);
        if (per_cu < 1) { fprintf(stderr, "kernel_launch: occupancy query says %d blocks per CU\n", per_cu); grid = -1; return; }
        grid = cus;
    }
    if (grid < 0) return;
    Params p{};
    p.x = (const float*)d_in[0]; p.norm1_g = (const float*)d_in[1]; p.w_in = (const float*)d_in[2]; p.w_dw = (const float*)d_in[3]; p.b_dw = (const float*)d_in[4];
    p.ln_g = (const float*)d_in[5]; p.ln_b = (const float*)d_in[6]; p.rel_bias = (const float*)d_in[7]; p.w_out = (const float*)d_in[8]; p.norm2_g = (const float*)d_in[9];
    p.w_group = (const float*)d_in[10]; p.b_group = (const float*)d_in[11]; p.w_er = (const float*)d_in[12]; p.b_er = (const float*)d_in[13];
    p.w_gate = (const float*)d_in[14]; p.w_up = (const float*)d_in[15]; p.w_down = (const float*)d_in[16]; p.final_g = (const float*)d_in[17];
    p.out = (float*)d_out; p.ws = (unsigned char*)d_ws;
    unsigned char* ws = (unsigned char*)d_ws;
    (void)hipMemsetAsync(ws + WS_CTL, 0, CTL_BYTES, stream);
    p.ph_lo = 0; p.ph_hi = 8; p.li = 0; p.pad = 0;
    hipLaunchKernelGGL(mega, dim3(grid), dim3(NTHR), LDS_BYTES, stream, p);
}
```

```cpp
#include <hip/hip_runtime.h>
#include <stdint.h>
#include <cstdio>

#ifndef PROBE_MOE
#define PROBE_MOE 0
#endif
#ifndef SWATCH
#define SWATCH 0
#endif
#ifndef SW_BLOCK
#define SW_BLOCK 0
#endif
#ifndef REP_PHASE
#define REP_PHASE -1
#endif

#define LAS __attribute__((address_space(3)))
#define GAS __attribute__((address_space(1)))
typedef unsigned short bf16_t;
typedef unsigned v4u __attribute__((ext_vector_type(4)));
typedef unsigned v2u __attribute__((ext_vector_type(2)));
typedef float f32x4 __attribute__((ext_vector_type(4)));
typedef float f32x16 __attribute__((ext_vector_type(16)));
typedef short bf16x8 __attribute__((ext_vector_type(8)));

constexpr int DM = 2048, SEQ = 8192, DCONV = 1024, DATT = 1024, HD = 64, NH = 16, DIN = 5120;
constexpr int CHUNK = 64, LEFT = 8, RCLIP = 128, NREL = 257, CW = 31;
constexpr int NG = 8, EPG = 8, NE = 64, DE = 512;
constexpr int LCAP = 8192;
constexpr int MTR = 384;
constexpr int NWAVES = 8, NTHR = 512;
constexpr float LOG2E = 1.4426950408889634f;
constexpr float QSCALE = 0.125f * LOG2E;
constexpr int X1GLD = DM + 64;
constexpr int NRT = 80;

constexpr size_t MiB = 1ull << 20;
constexpr size_t WS_CTL = 0, CTL_BYTES = 1 * MiB;
constexpr size_t CTL_CNT = 524288;
constexpr size_t WS_LTK = 1 * MiB, WS_LGT = 3 * MiB, WS_RSTD2 = 5 * MiB, WS_SSP = 6 * MiB, WS_WRT = 7 * MiB;
constexpr size_t WS_WINT = 8 * MiB, WS_WOUTT = 28 * MiB, WS_HB = 36 * MiB, WS_U = 68 * MiB;
constexpr size_t WS_QH = 84 * MiB, WS_KH = 100 * MiB, WS_VH = 116 * MiB, WS_MIX = 132 * MiB;
constexpr size_t WS_X1 = 164 * MiB, WS_X1G = 344 * MiB  , WS_HM = 260 * MiB, WS_Y = 280 * MiB;
constexpr size_t WS_LRS = 384 * MiB;
constexpr size_t WS_END = 386 * MiB;

struct Params {
    const float *x, *norm1_g, *w_in, *w_dw, *b_dw, *ln_g, *ln_b, *rel_bias, *w_out, *norm2_g, *w_group, *b_group, *w_er, *b_er, *w_gate, *w_up, *w_down, *final_g;
    float* out; unsigned char* ws;
    int ph_lo, ph_hi, li, pad;
};

typedef const __attribute__((address_space(4))) Params* CParams;
__device__ __forceinline__ CParams kparams() { CParams kp = (CParams)__builtin_amdgcn_kernarg_segment_ptr(); asm volatile("" : "+s"(kp)); return kp; }
__device__ __forceinline__ CParams relaunder(CParams kp) { asm volatile("" : "+s"(kp)); return kp; }

__device__ __forceinline__ float bf2f(unsigned b) { return __uint_as_float(b << 16); }
__device__ __forceinline__ unsigned f2bf(float f) { unsigned u = __float_as_uint(f); return (u + 0x7fffu + ((u >> 16) & 1u)) >> 16; }
__device__ __forceinline__ unsigned pk2(float lo, float hi) { return f2bf(lo) | (f2bf(hi) << 16); }
__device__ __forceinline__ float wave_sum(float v) {
#pragma unroll
    for (int o = 1; o < 64; o <<= 1) v += __shfl_xor(v, o);
    return v;
}
__device__ __forceinline__ float wave_max(float v) {
#pragma unroll
    for (int o = 1; o < 64; o <<= 1) v = fmaxf(v, __shfl_xor(v, o));
    return v;
}
__device__ __forceinline__ float sigmoidf_(float x) { return 1.f / (1.f + __expf(-x)); }
__host__ __device__ __forceinline__ int wint_row(int n) {
    if (n < 1024) return 256 * (n >> 7) + (n & 127);
    if (n < 2048) { const int m = n - 1024; return 256 * (m >> 7) + 128 + (m & 127); }
    return n;
}

__device__ __forceinline__ void p0_transpose_item(const float* W, int ldw, int k0, int n0, bf16_t* WT, int K, int orow0, LAS float* scr, int lane) {
#pragma unroll 8
    for (int i = 0; i < 32; ++i) { const int kk = 2 * i + (lane >> 5); scr[kk * 33 + (lane & 31)] = W[(size_t)(k0 + kk) * ldw + n0 + (lane & 31)]; }
    asm volatile("s_waitcnt lgkmcnt(0)" ::: "memory");
    const int c = lane & 7;
#pragma unroll
    for (int j = 0; j < 4; ++j) { const int n = (lane >> 3) + 8 * j; const LAS float* s = scr + (8 * c) * 33 + n;
        v4u o; o.x = pk2(s[0 * 33], s[1 * 33]); o.y = pk2(s[2 * 33], s[3 * 33]); o.z = pk2(s[4 * 33], s[5 * 33]); o.w = pk2(s[6 * 33], s[7 * 33]);
        *(v4u*)(WT + (size_t)(orow0 + n) * K + k0 + 8 * c) = o; }
    asm volatile("s_waitcnt lgkmcnt(0)" ::: "memory");
}

__device__ __forceinline__ void phase_prologue(CParams P, int vcu, int G, LAS unsigned char* lds) {
    const int tid = threadIdx.x, lane = tid & 63, wave = __builtin_amdgcn_readfirstlane(tid >> 6);
    LAS float* scr = (LAS float*)(lds + wave * 16384);
    const int gw = vcu * NWAVES + wave, NGW = G * NWAVES;
    bf16_t* WinT = (bf16_t*)(P->ws + WS_WINT); bf16_t* WoutT = (bf16_t*)(P->ws + WS_WOUTT); bf16_t* WrT = (bf16_t*)(P->ws + WS_WRT);
    bf16_t* Hb = (bf16_t*)(P->ws + WS_HB);
    for (int m = gw; m < SEQ; m += NGW) {
        const f32x4* xr = (const f32x4*)(P->x + (size_t)m * DM) + lane; const f32x4* gr = (const f32x4*)P->norm1_g + lane;
        f32x4 v[8]; float s = 0.f;
#pragma unroll
        for (int j = 0; j < 8; ++j) { v[j] = xr[64 * j]; s += (v[j].x * v[j].x + v[j].y * v[j].y) + (v[j].z * v[j].z + v[j].w * v[j].w); }
        const float rstd = rsqrtf(wave_sum(s) * (1.f / DM) + 1e-6f);
        v2u* o8 = (v2u*)(Hb + (size_t)m * DM) + lane;
#pragma unroll
        for (int j = 0; j < 8; ++j) { const f32x4 g = gr[64 * j]; v2u o; o.x = pk2(v[j].x * rstd * g.x, v[j].y * rstd * g.y); o.y = pk2(v[j].z * rstd * g.z, v[j].w * rstd * g.w); o8[64 * j] = o; }
    }
    constexpr int I_IN = (DM / 64) * (DIN / 32), I_OUT = (DM / 64) * (DM / 32);
    constexpr int NITEMS = I_IN + I_OUT;
    for (int it = gw; it < NITEMS; it += NGW) {
        int r = it;
        if (r < I_IN) { const int nb = r % (DIN / 32), kb = r / (DIN / 32); p0_transpose_item(P->w_in, DIN, 64 * kb, 32 * nb, WinT, DM, wint_row(32 * nb), scr, lane); continue; } r -= I_IN;
        { const int nb = r % (DM / 32), kb = r / (DM / 32); p0_transpose_item(P->w_out, DM, 64 * kb, 32 * nb, WoutT, DM, 32 * nb, scr, lane); }
    }
    for (int idx = (vcu * NTHR + tid); idx < NRT * DM; idx += G * NTHR) {
        const int n = idx / DM, k = idx % DM;
        float v = 0.f; if (n < NG) v = P->w_group[k * NG + n]; else if (n < NG + NE) v = P->w_er[k * NE + (n - NG)];
        WrT[idx] = (bf16_t)f2bf(v);
    }
}

constexpr int CONV_T = 16, CONV_ROWS = CONV_T + CW - 1;
constexpr int CONV_LDS_RED = 96 * 1024;
__device__ __forceinline__ void conv_item(CParams P, int item, LAS unsigned char* lds) {
    const int tid = threadIdx.x, lane = tid & 63, wave = tid >> 6;
    const bf16_t* U = (const bf16_t*)(P->ws + WS_U); bf16_t* MIX = (bf16_t*)(P->ws + WS_MIX);
    const int t0 = item * CONV_T;
    __syncthreads();
    for (int idx = tid; idx < CONV_ROWS * 128; idx += NTHR) {
        const int r = idx >> 7, ch = idx & 127, t = t0 - (CW - 1) + r;
        v4u v = {0u, 0u, 0u, 0u}; if (t >= 0) v = *(const v4u*)(U + (size_t)t * DCONV + ch * 8);
        *(LAS v4u*)(lds + r * 2048 + ch * 16) = v;
    }
    float w0[CW], w1[CW];
#pragma unroll
    for (int j = 0; j < CW; ++j) { const float2 w = *(const float2*)(P->w_dw + j * DCONV + 2 * tid); w0[j] = w.x; w1[j] = w.y; }
    const float2 bb = *(const float2*)(P->b_dw + 2 * tid);
    float a0[CONV_T], a1[CONV_T];
#pragma unroll
    for (int t = 0; t < CONV_T; ++t) { a0[t] = bb.x; a1[t] = bb.y; }
    __syncthreads();
#pragma unroll
    for (int r = 0; r < CONV_ROWS; ++r) {
        const unsigned u2 = *(const LAS unsigned*)(lds + r * 2048 + tid * 4);
        const float ua = bf2f(u2 & 0xffffu), ub = bf2f(u2 >> 16);
#pragma unroll
        for (int t = 0; t < CONV_T; ++t) { const int j = r - t; if (j >= 0 && j < CW) { a0[t] += w0[j] * ua; a1[t] += w1[j] * ub; } }
    }
    LAS float* red = (LAS float*)(lds + CONV_LDS_RED);
    LAS float* st = red + NWAVES * CONV_T * 2;
#pragma unroll
    for (int t = 0; t < CONV_T; ++t) {
        const float s = wave_sum(a0[t] + a1[t]), q = wave_sum(a0[t] * a0[t] + a1[t] * a1[t]);
        if (lane == 0) { red[(wave * CONV_T + t) * 2] = s; red[(wave * CONV_T + t) * 2 + 1] = q; }
    }
    __syncthreads();
    if (tid < CONV_T) {
        float s = 0.f, q = 0.f;
        for (int w = 0; w < NWAVES; ++w) { s += red[(w * CONV_T + tid) * 2]; q += red[(w * CONV_T + tid) * 2 + 1]; }
        const float mu = s * (1.f / DCONV), var = fmaxf(q * (1.f / DCONV) - mu * mu, 0.f);
        st[tid * 2] = mu; st[tid * 2 + 1] = rsqrtf(var + 1e-5f);
    }
    __syncthreads();
    const float2 lg = *(const float2*)(P->ln_g + 2 * tid), lb = *(const float2*)(P->ln_b + 2 * tid);
#pragma unroll
    for (int t = 0; t < CONV_T; ++t) {
        const float mu = st[t * 2], rs = st[t * 2 + 1];
        const float u0 = (a0[t] - mu) * rs * lg.x + lb.x, u1 = (a1[t] - mu) * rs * lg.y + lb.y;
        *(unsigned*)(MIX + (size_t)(t0 + t) * DM + 2 * tid) = pk2(u0 * sigmoidf_(u0), u1 * sigmoidf_(u1));
    }
}

__device__ __forceinline__ void phase_final(CParams P, int vcu, int G) {
    const int tid = threadIdx.x, lane = tid & 63, wave = tid >> 6;
    const bf16_t* X1 = (const bf16_t*)(P->ws + WS_X1); const bf16_t* Y = (const bf16_t*)(P->ws + WS_Y);
    for (int m = vcu * NWAVES + wave; m < SEQ; m += G * NWAVES) {
        const v2u* xr = (const v2u*)(X1 + (size_t)m * DM) + lane;
        const v2u* y0 = (const v2u*)(Y + (size_t)(2 * m) * DM) + lane; const v2u* y1 = (const v2u*)(Y + (size_t)(2 * m + 1) * DM) + lane;
        f32x4 v[8]; float s = 0.f;
#pragma unroll
        for (int j = 0; j < 8; ++j) {
            { const v2u xv = xr[64 * j]; v[j] = (f32x4){bf2f(xv.x & 0xffffu), bf2f(xv.x >> 16), bf2f(xv.y & 0xffffu), bf2f(xv.y >> 16)}; } const v2u a = y0[64 * j], b = y1[64 * j];
            v[j].x += bf2f(a.x & 0xffffu) + bf2f(b.x & 0xffffu); v[j].y += bf2f(a.x >> 16) + bf2f(b.x >> 16);
            v[j].z += bf2f(a.y & 0xffffu) + bf2f(b.y & 0xffffu); v[j].w += bf2f(a.y >> 16) + bf2f(b.y >> 16);
            s += (v[j].x * v[j].x + v[j].y * v[j].y) + (v[j].z * v[j].z + v[j].w * v[j].w);
        }
        const float rstd = rsqrtf(wave_sum(s) * (1.f / DM) + 1e-6f);
        f32x4* o = (f32x4*)(P->out + (size_t)m * DM) + lane; const f32x4* g = (const f32x4*)P->final_g + lane;
#pragma unroll
        for (int j = 0; j < 8; ++j) o[64 * j] = v[j] * rstd * g[64 * j];
    }
}

namespace g8 {
constexpr int BM = 256, BK = 64, HALF = 128, HTB = HALF * BK * 2, STAGE_BYTES = 8 * HTB, NXCD = 8, WGM = 8;
__host__ __device__ __forceinline__ int lds_byte(int r, int c) { const int st = (r >> 4) * 2 + (c >> 5), rr = r & 15, cc = c & 31, ob = rr * 64 + cc * 2; return st * 1024 + (ob ^ (((ob >> 9) & 1) << 5)); }
__host__ __device__ __forceinline__ void stage_rc(int b, int& R, int& C) { const int st = b / 1024, sb = b % 1024, swz = sb ^ (((sb >> 9) & 1) << 5); R = (st >> 1) * 16 + swz / 64; C = (st & 1) * 32 + (swz % 64) / 2; }
__host__ __device__ __forceinline__ int perm32(int rho) { const int n = rho >> 4, i = rho & 15; return 8 * (i >> 2) + 4 * n + (i & 3); }
__device__ __forceinline__ unsigned cvt_pk_bf16(float lo, float hi) { unsigned r; asm volatile("v_cvt_pk_bf16_f32 %0, %1, %2" : "=v"(r) : "v"(lo), "v"(hi)); return r; }

struct Unit { const char* a; const char* b; int i0, i1, i2; };

template <class Epi, class Sched, bool GATHER>
__device__ __forceinline__ void gemm_phase(LAS unsigned char* lds, const int K, const size_t astep, const size_t bstep, const Sched& S, const Epi& E) {
    const int tid = threadIdx.x, wid = __builtin_amdgcn_readfirstlane(tid >> 6), lane = tid & 63, wr = wid >> 2, wc = wid & 3, fr = lane & 15, fq = lane >> 4;
    const int nt = K / BK;
    unsigned voffB[2], voffA0[2], voffA1[2];
#pragma unroll
    for (int i = 0; i < 2; ++i) { int R, C; stage_rc(tid * 16 + i * 8192, R, C); const int Rb = (R & ~31) + perm32(R & 31);
        voffB[i] = (unsigned)(Rb * K + C) * 2u; voffA0[i] = (unsigned)(R * K + C) * 2u; voffA1[i] = voffA0[i]; }
    const size_t kstep = (size_t)(BK * 2);
    const unsigned ldsw = (unsigned)wid * 1024u;
    const int aoff = lds_byte(wr * 64 + fr, fq * 8), boff = lds_byte(wc * 32 + fr, fq * 8);
#define G8_SA(b, h) (((b) * 2 + (h)) * HTB)
#define G8_SB(b, h) ((4 + (b) * 2 + (h)) * HTB)
#define G8_STAGE(bufoff, gbase, voff) do { _Pragma("unroll") for (int _i = 0; _i < 2; ++_i) \
        __builtin_amdgcn_global_load_lds((const unsigned*)((const char*)(gbase) + (voff)[_i]), (LAS unsigned*)(lds + (bufoff) + ldsw + _i * 8192), 16, 0, 0); } while (0)
#define G8_LDA(dst, b, h) do { _Pragma("unroll") for (int m = 0; m < 4; ++m) _Pragma("unroll") for (int k = 0; k < 2; ++k) dst[m][k] = *(const LAS bf16x8*)(lds + G8_SA(b, h) + aoff + m * 2048 + k * 1024); } while (0)
#define G8_LDB(dst, b, h) do { _Pragma("unroll") for (int n = 0; n < 2; ++n) _Pragma("unroll") for (int k = 0; k < 2; ++k) dst[n][k] = *(const LAS bf16x8*)(lds + G8_SB(b, h) + boff + n * 2048 + k * 1024); } while (0)
#define G8_MMA(ai, bj, At, Bt) do { __builtin_amdgcn_s_setprio(1); _Pragma("unroll") for (int m = 0; m < 4; ++m) _Pragma("unroll") for (int n = 0; n < 2; ++n) _Pragma("unroll") for (int k = 0; k < 2; ++k) \
        acc[ai][bj][m][n] = __builtin_amdgcn_mfma_f32_16x16x32_bf16(Bt[n][k], At[m][k], acc[ai][bj][m][n], 0, 0, 0); __builtin_amdgcn_s_setprio(0); } while (0)
#define G8_WAIT_V(n) asm volatile("s_waitcnt vmcnt(" #n ")" ::: "memory")
#define G8_WAIT_L(n) asm volatile("s_waitcnt lgkmcnt(" #n ")" ::: "memory")
#define G8_BAR __builtin_amdgcn_s_barrier()
#define G8_SCHED __builtin_amdgcn_sched_barrier(0)
#define G8_GOFF(u) do { if (GATHER) { _Pragma("unroll") for (int _i = 0; _i < 2; ++_i) { int R_, C_; stage_rc(tid * 16 + _i * 8192, R_, C_); \
        voffA0[_i] = S.row_off(u, R_) + (unsigned)C_ * 2u; voffA1[_i] = S.row_off(u, R_ + HALF) + (unsigned)C_ * 2u; } } } while (0)
    Unit cur, nxt; int ui = 0;
    if (!S.next(0, cur)) return;
    f32x4 acc[2][2][4][2];
#pragma unroll
    for (int a = 0; a < 2; ++a)
#pragma unroll
        for (int b = 0; b < 2; ++b)
#pragma unroll
            for (int m = 0; m < 4; ++m)
#pragma unroll
                for (int n = 0; n < 2; ++n) acc[a][b][m][n] = (f32x4){0.f, 0.f, 0.f, 0.f};
    bf16x8 At[4][2], B0[2][2], B1[2][2];
    const char* cA0 = cur.a; const char* cB0 = cur.b;
#define cA1 (cA0 + astep)
#define cB1 (cB0 + bstep)
    G8_GOFF(cur);
    G8_STAGE(G8_SB(0, 0), cB0, voffB); G8_STAGE(G8_SB(0, 1), cB1, voffB); G8_STAGE(G8_SA(0, 0), cA0, voffA0); G8_STAGE(G8_SA(0, 1), cA1, voffA1);
    if (wr == 1) G8_BAR;
    G8_WAIT_V(2); G8_BAR;
    G8_STAGE(G8_SB(1, 0), cB0 + kstep, voffB); G8_STAGE(G8_SA(1, 0), cA0 + kstep, voffA0); G8_STAGE(G8_SB(1, 1), cB1 + kstep, voffB);
    G8_WAIT_V(6); G8_BAR;
    for (;;) {
        const bool has_next = S.next(ui + 1, nxt);
        const char* nA0 = has_next ? nxt.a : cA0; const char* nB0 = has_next ? nxt.b : cB0;
        for (int t = 0; t < nt; t += 2) {
            const bool last = (t == nt - 2);
            const char* a1h = cA1 + (size_t)(t + 1) * kstep;
            const char* a2_0 = last ? nA0 : cA0 + (size_t)(t + 2) * kstep; const char* a2_1 = a2_0 + astep;
            const char* b2_0 = last ? nB0 : cB0 + (size_t)(t + 2) * kstep; const char* b2_1 = b2_0 + bstep;
            const char* a3_0 = a2_0 + kstep; const char* b3_0 = b2_0 + kstep; const char* b3_1 = b2_1 + kstep;
            G8_LDB(B0, 0, 0); G8_LDB(B1, 0, 1); G8_SCHED; G8_LDA(At, 0, 0); G8_STAGE(G8_SA(1, 1), a1h, voffA1);
            G8_WAIT_V(8); G8_WAIT_L(0); G8_BAR; G8_MMA(0, 0, At, B0); G8_MMA(0, 1, At, B1); G8_BAR; G8_SCHED;
            if (GATHER) { if (last && has_next) { G8_GOFF(nxt); } }
            G8_LDA(At, 0, 1); G8_STAGE(G8_SB(0, 0), b2_0, voffB); G8_STAGE(G8_SB(0, 1), b2_1, voffB); G8_STAGE(G8_SA(0, 0), a2_0, voffA0);
            G8_WAIT_V(8); G8_WAIT_L(0); G8_BAR; G8_MMA(1, 0, At, B0); G8_MMA(1, 1, At, B1); G8_BAR; G8_SCHED;
            G8_LDB(B0, 1, 0); G8_LDB(B1, 1, 1); G8_SCHED; G8_LDA(At, 1, 0); G8_STAGE(G8_SA(0, 1), a2_1, voffA1);
            G8_WAIT_V(8); G8_WAIT_L(0); G8_BAR; G8_MMA(0, 0, At, B0); G8_MMA(0, 1, At, B1); G8_BAR; G8_SCHED;
            G8_LDA(At, 1, 1); G8_STAGE(G8_SB(1, 0), b3_0, voffB); G8_STAGE(G8_SB(1, 1), b3_1, voffB); G8_STAGE(G8_SA(1, 0), a3_0, voffA0);
            G8_WAIT_V(8); G8_WAIT_L(0); G8_BAR; G8_MMA(1, 0, At, B0); G8_MMA(1, 1, At, B1); G8_BAR; G8_SCHED;
        }
        if (wr == 0) G8_BAR;
        E(acc, cur, wr, wc, fr, fq);
        if (!has_next) break;
#pragma unroll
        for (int a = 0; a < 2; ++a)
#pragma unroll
            for (int b = 0; b < 2; ++b)
#pragma unroll
                for (int m = 0; m < 4; ++m)
#pragma unroll
                    for (int n = 0; n < 2; ++n) acc[a][b][m][n] = (f32x4){0.f, 0.f, 0.f, 0.f};
        cur = nxt; cA0 = nA0; cB0 = nB0; ++ui;
        if (wr == 1) G8_BAR;
    }
    G8_WAIT_V(0);
    G8_BAR;
#undef G8_SA
#undef G8_SB
#undef G8_STAGE
#undef G8_LDA
#undef G8_LDB
#undef G8_MMA
#undef G8_WAIT_V
#undef G8_WAIT_L
#undef G8_BAR
#undef G8_SCHED
#undef G8_GOFF
#undef cA1
#undef cB1
}

struct DenseOrder {
    int nM, nN, nwg, G, c, K; const char* A; const char* Bt;
    __device__ __forceinline__ void init(const void* A_, const void* Bt_, int M, int N, int K_, int G_, int c_) { A = (const char*)A_; Bt = (const char*)Bt_; nM = M / BM; nN = N / BM; nwg = nM * nN; G = G_; c = c_; K = K_; }
    __device__ __forceinline__ bool next(int i, Unit& u) const {
        const long L = (long)i * G + c; if (L >= nwg) return false;
        int wgid = (int)L; { const int q = nwg / NXCD, r = nwg % NXCD, xcd = wgid % NXCD, off = wgid / NXCD; wgid = (xcd < r ? xcd * (q + 1) : r * (q + 1) + (xcd - r) * q) + off; }
        const int nig = WGM * nN, gid = wgid / nig, fm = gid * WGM, gsz = (nM - fm) < WGM ? (nM - fm) : WGM;
        const int pm = fm + ((wgid % nig) % gsz), pn = (wgid % nig) / gsz;
        const size_t hstep = (size_t)HALF * K * 2;
        u.a = A + (size_t)pm * 2 * hstep; u.b = Bt + (size_t)pn * 2 * hstep; u.i0 = pm; u.i1 = pn; u.i2 = 0; return true;
    }
    __device__ __forceinline__ unsigned row_off(const Unit&, int) const { return 0u; }
};

struct EpiIn {
    CParams P;
    __device__ __forceinline__ void operator()(const f32x4 (&acc)[2][2][4][2], const Unit& u, int wr, int wc, int fr, int fq) const {
        unsigned char* ws = relaunder(P)->ws;
        bf16_t* U = (bf16_t*)(ws + WS_U); bf16_t* QKV = (bf16_t*)(ws + WS_QH);
        const int pm = u.i0, pn = u.i1;
        const int row0 = pm * BM + wr * 64 + fr;
        if (pn < 8) {
            bf16_t* base = U + (size_t)row0 * DCONV + pn * 128 + wc * 32 + 8 * fq;
#pragma unroll
            for (int ai = 0; ai < 2; ++ai)
#pragma unroll
                for (int m = 0; m < 4; ++m) {
                    float r[8];
#pragma unroll
                    for (int n = 0; n < 2; ++n)
#pragma unroll
                        for (int i = 0; i < 4; ++i) { const float v = acc[ai][0][m][n][i], g = acc[ai][1][m][n][i]; r[4 * n + i] = v * __builtin_amdgcn_rcpf(1.f + __expf(-g)); }
                    v4u w; w.x = cvt_pk_bf16(r[0], r[1]); w.y = cvt_pk_bf16(r[2], r[3]); w.z = cvt_pk_bf16(r[4], r[5]); w.w = cvt_pk_bf16(r[6], r[7]);
                    *(v4u*)(base + (size_t)(ai * HALF + m * 16) * DCONV) = w;
                }
        } else {
            const int which = (pn - 8) >> 2, hq = 4 * ((pn - 8) & 3) + (wc >> 1);
            const float sc = which == 0 ? QSCALE : 1.f;
            bf16_t* base = QKV + (size_t)which * ((size_t)NH * SEQ * HD) + (size_t)row0 * HD + (wc & 1) * 32 + 8 * fq;
#pragma unroll
            for (int ai = 0; ai < 2; ++ai)
#pragma unroll
                for (int m = 0; m < 4; ++m)
#pragma unroll
                    for (int bj = 0; bj < 2; ++bj) {
                        const f32x4 v0 = acc[ai][bj][m][0] * sc, v1 = acc[ai][bj][m][1] * sc;
                        v4u w; w.x = cvt_pk_bf16(v0[0], v0[1]); w.y = cvt_pk_bf16(v0[2], v0[3]); w.z = cvt_pk_bf16(v1[0], v1[1]); w.w = cvt_pk_bf16(v1[2], v1[3]);
                        *(v4u*)(base + ((size_t)(hq + 2 * bj) * SEQ + ai * HALF + m * 16) * HD) = w;
                    }
        }
    }
};
struct EpiOut {
    CParams P;
    __device__ __forceinline__ void operator()(const f32x4 (&acc)[2][2][4][2], const Unit& u, int wr, int wc, int fr, int fq) const {
        CParams Q = relaunder(P);
        const float* x = Q->x; const float* g2 = Q->norm2_g; unsigned char* ws = Q->ws;
        bf16_t* X1 = (bf16_t*)(ws + WS_X1); bf16_t* X1G = (bf16_t*)(ws + WS_X1G); float* SSP = (float*)(ws + WS_SSP);
        const int pm = u.i0, pn = u.i1;
        const int row0 = pm * BM + wr * 64 + fr, col0 = pn * BM + wc * 32 + 8 * fq;
        f32x4 gv[2][2];
#pragma unroll
        for (int bj = 0; bj < 2; ++bj)
#pragma unroll
            for (int n = 0; n < 2; ++n) gv[bj][n] = *(const f32x4*)(g2 + col0 + bj * HALF + 4 * n);
#pragma unroll
        for (int ai = 0; ai < 2; ++ai)
#pragma unroll
            for (int m = 0; m < 4; ++m) {
                const int row = row0 + ai * HALF + m * 16; const size_t off = (size_t)row * DM + col0;
                float q = 0.f;
#pragma unroll
                for (int bj = 0; bj < 2; ++bj) {
                    const f32x4 s0 = *(const f32x4*)(x + off + bj * HALF) + acc[ai][bj][m][0], s1 = *(const f32x4*)(x + off + bj * HALF + 4) + acc[ai][bj][m][1];
                    { v4u w1; w1.x = cvt_pk_bf16(s0[0], s0[1]); w1.y = cvt_pk_bf16(s0[2], s0[3]); w1.z = cvt_pk_bf16(s1[0], s1[1]); w1.w = cvt_pk_bf16(s1[2], s1[3]); *(v4u*)(X1 + off + bj * HALF) = w1; }
                    q += (s0[0] * s0[0] + s0[1] * s0[1]) + (s0[2] * s0[2] + s0[3] * s0[3]) + (s1[0] * s1[0] + s1[1] * s1[1]) + (s1[2] * s1[2] + s1[3] * s1[3]);
                    const f32x4 t0 = s0 * gv[bj][0], t1 = s1 * gv[bj][1];
                    v4u w; w.x = cvt_pk_bf16(t0[0], t0[1]); w.y = cvt_pk_bf16(t0[2], t0[3]); w.z = cvt_pk_bf16(t1[0], t1[1]); w.w = cvt_pk_bf16(t1[2], t1[3]);
                    *(v4u*)(X1G + (size_t)row * X1GLD + col0 + bj * HALF) = w;
                }
                q += __shfl_xor(q, 16); q += __shfl_xor(q, 32);
                if (fq == 0) SSP[(size_t)(pn * 4 + wc) * SEQ + row] = q;
            }
    }
};
constexpr int TAB_TS = 0, TAB_OS = 65, TAB_CN = 130, TAB_TI = 200;
}


#define XB_TMO      128
#define XB_XCNT(j)  (256  + 64 * (j))
#define XB_XSUB(j)  (1280 + 64 * (j))
#define XB_XGEN(j)  (2304 + 64 * (j))
#define XB_TOP      3328
#define XB_TOPGEN   3392
#define XCD_BAR_WORDS 3456
#define XB_SPIN_CAP (1u << 18)
__device__ __forceinline__ unsigned xb_ld(unsigned* p)              { return __hip_atomic_load(p, __ATOMIC_RELAXED, __HIP_MEMORY_SCOPE_AGENT); }
__device__ __forceinline__ unsigned xb_add(unsigned* p, unsigned v) { return __hip_atomic_fetch_add(p, v, __ATOMIC_RELAXED, __HIP_MEMORY_SCOPE_AGENT); }
__device__ __forceinline__ unsigned xb_xcc_id() { return (unsigned)__builtin_amdgcn_s_getreg((3 << 11) | 20) & 0xFu; }
#define XB_SPIN(cond, bar) do { unsigned _sp = 0; while (cond) { __builtin_amdgcn_s_sleep(1); \
    if ((++_sp & 255u) == 0u) { if (xb_ld(&(bar)[XB_TMO])) break; if (_sp > XB_SPIN_CAP) { atomicAdd(&(bar)[XB_TMO], 1u); break; } } } } while (0)
struct XcdBarrier { unsigned* bar; unsigned x; volatile LAS unsigned* st; };
__device__ __forceinline__ XcdBarrier xcd_barrier_post(unsigned* bar, volatile LAS unsigned* st) {
    XcdBarrier b; b.bar = bar; b.x = xb_xcc_id(); b.st = st;
    if (threadIdx.x == 0) (void)xb_add(&bar[XB_XCNT(b.x)], 1u);
    return b;
}
__device__ __forceinline__ void xcd_barrier_complete(unsigned* bar, unsigned x, unsigned& nloc, unsigned& nx) {
    const unsigned G = gridDim.x * gridDim.y * gridDim.z;
    unsigned sum, cnt, mine, sp = 0u;
    for (;;) {
        sum = 0u; cnt = 0u; mine = 0u;
#pragma unroll
        for (unsigned j = 0; j < 16; ++j) { const unsigned c = xb_ld(&bar[XB_XCNT(j)]); sum += c; cnt += (c > 0u) ? 1u : 0u; mine = (j == x) ? c : mine; }
        if (sum == G) break;
        __builtin_amdgcn_s_sleep(1);
        if ((++sp & 255u) == 0u) { if (xb_ld(&bar[XB_TMO])) break; if (sp > XB_SPIN_CAP) { atomicAdd(&bar[XB_TMO], 1u); break; } }
    }
    nloc = mine > 0u ? mine : 1u; nx = cnt > 0u ? cnt : 1u;
}
__device__ __forceinline__ void xcd_barrier(const XcdBarrier& b) {
    asm volatile("s_waitcnt vmcnt(0)" ::: "memory");
    __syncthreads();
    if (threadIdx.x == 0) {
        unsigned* bar = b.bar;
        __builtin_amdgcn_s_waitcnt(0);
        unsigned nloc = b.st[0], nx = b.st[1];
        if (nloc == 0u) { xcd_barrier_complete(bar, b.x, nloc, nx); b.st[0] = nloc; b.st[1] = nx; }
        const unsigned old = xb_add(&bar[XB_XSUB(b.x)], 1u);
        const unsigned gen = old / nloc;
        if (old + 1u == (gen + 1u) * nloc) {
            __builtin_amdgcn_fence(__ATOMIC_RELEASE, "agent");
            asm volatile("s_waitcnt vmcnt(0)" ::: "memory");
            const unsigned og = xb_add(&bar[XB_TOP], 1u);
            const unsigned tg = og / nx;
            if (og + 1u == (tg + 1u) * nx) xb_add(&bar[XB_TOPGEN], 1u);
            else XB_SPIN(xb_ld(&bar[XB_TOPGEN]) == tg, bar);
            __builtin_amdgcn_fence(__ATOMIC_ACQUIRE, "agent");
            xb_add(&bar[XB_XGEN(b.x)], 1u);
            asm volatile("s_waitcnt vmcnt(0)" ::: "memory");
        } else {
            XB_SPIN(xb_ld(&bar[XB_XGEN(b.x)]) == gen, bar);
            __builtin_amdgcn_fence(__ATOMIC_ACQUIRE, "agent");
            asm volatile("s_waitcnt vmcnt(0)" ::: "memory");
        }
    }
    __syncthreads();
}


typedef short v4i16_t __attribute__((ext_vector_type(4)));
constexpr int ATT_BUF = 16384, ATT_V = 8192, ATT_BIAS = 32768;
__device__ __forceinline__ int crow(int r, int hi) { return (r & 3) + 8 * (r >> 2) + 4 * hi; }
__device__ __forceinline__ void attn_unit(CParams P, int h, int cg, LAS unsigned char* lds) {
    const int tid = threadIdx.x, lane = tid & 63, wave = __builtin_amdgcn_readfirstlane(tid >> 6), r32 = lane & 31, hi = lane >> 5;
    unsigned char* ws = P->ws;
    const bf16_t* Qh = (const bf16_t*)(ws + WS_QH) + (size_t)h * SEQ * HD; const bf16_t* Kh = (const bf16_t*)(ws + WS_KH) + (size_t)h * SEQ * HD;
    const bf16_t* Vh = (const bf16_t*)(ws + WS_VH) + (size_t)h * SEQ * HD; bf16_t* MIX = (bf16_t*)(ws + WS_MIX);
    const int c = cg * 8 + wave;
    LAS float* bias = (LAS float*)(lds + ATT_BIAS);
    __syncthreads();
    for (int i = tid; i < NREL; i += NTHR) bias[i] = P->rel_bias[h * NREL + i] * LOG2E;
    bf16x8 qf[2][4];
#pragma unroll
    for (int qb = 0; qb < 2; ++qb)
#pragma unroll
        for (int s = 0; s < 4; ++s) qf[qb][s] = *(const bf16x8*)(Qh + (size_t)(c * 64 + qb * 32 + r32) * HD + s * 16 + hi * 8);
#pragma unroll
    for (int qb = 0; qb < 2; ++qb)
#pragma unroll
        for (int s = 0; s < 4; ++s) asm volatile("" : "+v"(qf[qb][s]));
    float mrun[2] = {-1e30f, -1e30f}, lrun[2] = {0.f, 0.f};
    f32x16 O[2][2];
#pragma unroll
    for (int a = 0; a < 2; ++a)
#pragma unroll
        for (int b = 0; b < 2; ++b)
#pragma unroll
            for (int r = 0; r < 16; ++r) O[a][b][r] = 0.f;
    const int kt0 = cg * 8 - 8 < 0 ? 0 : cg * 8 - 8, kt1 = cg * 8 + 7;
    const int skey = tid >> 3, sch = tid & 7;
    const bf16_t* Kg = Kh + (size_t)skey * HD + sch * 8; const bf16_t* Vg = Vh + (size_t)skey * HD + sch * 8;
    const int kwoff = skey * 128 + ((sch ^ (skey & 7)) << 4), vwoff = ATT_V + skey * 128 + (sch << 4);
    v4u kreg = *(const v4u*)(Kg + (size_t)kt0 * 64 * HD), vreg = *(const v4u*)(Vg + (size_t)kt0 * 64 * HD);
    *(LAS v4u*)(lds + kwoff) = kreg; *(LAS v4u*)(lds + vwoff) = vreg;
    __syncthreads();
    const int kroff = r32 * 128;
    const int vq = (lane & 15) >> 2, vp = lane & 3, vg1 = (lane >> 4) & 1;
    const int vroff = ATT_V + (4 * hi + vq) * 128 + (16 * vg1 + 4 * vp) * 2;
    for (int kt = kt0; kt <= kt1; ++kt) {
        const int cur = (kt - kt0) & 1;
        if (kt < kt1) { kreg = *(const v4u*)(Kg + (size_t)(kt + 1) * 64 * HD); vreg = *(const v4u*)(Vg + (size_t)(kt + 1) * 64 * HD); }
        if (kt >= c - 8 && kt <= c) {
            const int tt = kt - (c - 8);
            LAS unsigned char* buf = lds + cur * ATT_BUF;
            bf16x8 kf[2][4];
#pragma unroll
            for (int kh = 0; kh < 2; ++kh)
#pragma unroll
                for (int s = 0; s < 4; ++s) kf[kh][s] = *(const LAS bf16x8*)(buf + kh * 4096 + kroff + (((2 * s + hi) ^ (r32 & 7)) << 4));
            bf16x8 pb[2][2][2];
#pragma unroll
            for (int qb = 0; qb < 2; ++qb) {
                f32x16 S0, S1;
#pragma unroll
                for (int r = 0; r < 16; ++r) { S0[r] = 0.f; S1[r] = 0.f; }
#pragma unroll
                for (int s = 0; s < 4; ++s) { S0 = __builtin_amdgcn_mfma_f32_32x32x16_bf16(kf[0][s], qf[qb][s], S0, 0, 0, 0); S1 = __builtin_amdgcn_mfma_f32_32x32x16_bf16(kf[1][s], qf[qb][s], S1, 0, 0, 0); }
                if (tt <= 5) { const float b = bias[2 * RCLIP];
#pragma unroll
                    for (int r = 0; r < 16; ++r) { S0[r] += b; S1[r] += b; } }
                else { const int base = LEFT * CHUNK - 64 * tt + qb * 32 + r32;
#pragma unroll
                    for (int r = 0; r < 16; ++r) { int d0 = base - crow(r, hi), d1 = d0 - 32;
                        d0 = d0 > RCLIP ? RCLIP : (d0 < -RCLIP ? -RCLIP : d0); d1 = d1 > RCLIP ? RCLIP : (d1 < -RCLIP ? -RCLIP : d1);
                        S0[r] += bias[d0 + RCLIP]; S1[r] += bias[d1 + RCLIP]; } }
                float mx = fmaxf(S0[0], S1[0]);
#pragma unroll
                for (int r = 1; r < 16; ++r) mx = fmaxf(mx, fmaxf(S0[r], S1[r]));
                mx = fmaxf(mx, __shfl_xor(mx, 32));
                const float mnew = fmaxf(mrun[qb], mx), alpha = __builtin_amdgcn_exp2f(mrun[qb] - mnew);
                mrun[qb] = mnew;
                float rs = 0.f;
#pragma unroll
                for (int r = 0; r < 16; ++r) { S0[r] = __builtin_amdgcn_exp2f(S0[r] - mnew); S1[r] = __builtin_amdgcn_exp2f(S1[r] - mnew); rs += S0[r] + S1[r]; }
                rs += __shfl_xor(rs, 32);
                lrun[qb] = lrun[qb] * alpha + rs;
#pragma unroll
                for (int r = 0; r < 16; ++r) { O[qb][0][r] *= alpha; O[qb][1][r] *= alpha; }
#pragma unroll
                for (int s2 = 0; s2 < 2; ++s2) {
                    v4u w0, w1;
                    w0.x = g8::cvt_pk_bf16(S0[8 * s2 + 0], S0[8 * s2 + 1]); w0.y = g8::cvt_pk_bf16(S0[8 * s2 + 2], S0[8 * s2 + 3]); w0.z = g8::cvt_pk_bf16(S0[8 * s2 + 4], S0[8 * s2 + 5]); w0.w = g8::cvt_pk_bf16(S0[8 * s2 + 6], S0[8 * s2 + 7]);
                    w1.x = g8::cvt_pk_bf16(S1[8 * s2 + 0], S1[8 * s2 + 1]); w1.y = g8::cvt_pk_bf16(S1[8 * s2 + 2], S1[8 * s2 + 3]); w1.z = g8::cvt_pk_bf16(S1[8 * s2 + 4], S1[8 * s2 + 5]); w1.w = g8::cvt_pk_bf16(S1[8 * s2 + 6], S1[8 * s2 + 7]);
                    pb[qb][0][s2] = __builtin_bit_cast(bf16x8, w0); pb[qb][1][s2] = __builtin_bit_cast(bf16x8, w1);
                }
            }
#pragma unroll
            for (int dh = 0; dh < 2; ++dh)
#pragma unroll
                for (int kh = 0; kh < 2; ++kh)
#pragma unroll
                    for (int s2 = 0; s2 < 2; ++s2) {
                        const LAS unsigned char* vp0 = buf + vroff + (32 * kh + 16 * s2) * 128 + 64 * dh;
                        const v4i16_t lo = __builtin_amdgcn_ds_read_tr16_b64_v4i16((LAS v4i16_t*)vp0);
                        const v4i16_t hv = __builtin_amdgcn_ds_read_tr16_b64_v4i16((LAS v4i16_t*)(vp0 + 8 * 128));
                        const bf16x8 vf = (bf16x8){lo[0], lo[1], lo[2], lo[3], hv[0], hv[1], hv[2], hv[3]};
                        O[0][dh] = __builtin_amdgcn_mfma_f32_32x32x16_bf16(vf, pb[0][kh][s2], O[0][dh], 0, 0, 0);
                        O[1][dh] = __builtin_amdgcn_mfma_f32_32x32x16_bf16(vf, pb[1][kh][s2], O[1][dh], 0, 0, 0);
                    }
        }
        if (kt < kt1) { LAS unsigned char* nb = lds + (cur ^ 1) * ATT_BUF; *(LAS v4u*)(nb + kwoff) = kreg; *(LAS v4u*)(nb + vwoff) = vreg; }
        __syncthreads();
    }
#pragma unroll
    for (int qb = 0; qb < 2; ++qb) {
        const float inv = 1.f / lrun[qb];
        bf16_t* orow = MIX + (size_t)(c * 64 + qb * 32 + r32) * DM + DCONV + h * HD + 4 * hi;
#pragma unroll
        for (int dh = 0; dh < 2; ++dh)
#pragma unroll
            for (int g = 0; g < 4; ++g) {
                v2u w; w.x = g8::cvt_pk_bf16(O[qb][dh][4 * g] * inv, O[qb][dh][4 * g + 1] * inv); w.y = g8::cvt_pk_bf16(O[qb][dh][4 * g + 2] * inv, O[qb][dh][4 * g + 3] * inv);
                *(v2u*)(orow + dh * 32 + 8 * g) = w;
            }
    }
}

constexpr int RT_RED = 0, RT_LOG = 8 * 32 * NRT * 4, RT_RS = RT_LOG + 32 * NRT * 4;
__device__ __forceinline__ void router_item(CParams P, int item, LAS unsigned char* lds) {
    const int tid = threadIdx.x, lane = tid & 63, wave = __builtin_amdgcn_readfirstlane(tid >> 6), fr = lane & 15, fq = lane >> 4;
    unsigned char* ws = P->ws;
    const bf16_t* X1G = (const bf16_t*)(ws + WS_X1G); const float* SSP = (const float*)(ws + WS_SSP); const bf16_t* WrT = (const bf16_t*)(ws + WS_WRT);
    float* RSTD2 = (float*)(ws + WS_RSTD2); int* cnt = (int*)(ws + WS_CTL + CTL_CNT); int* ltk = (int*)(ws + WS_LTK); float* lgt = (float*)(ws + WS_LGT);
    const int row0 = item * 32;
    LAS float* red = (LAS float*)(lds + RT_RED); LAS float* lg = (LAS float*)(lds + RT_LOG); LAS float* rsl = (LAS float*)(lds + RT_RS);
    f32x4 acc[2][5];
#pragma unroll
    for (int rb = 0; rb < 2; ++rb)
#pragma unroll
        for (int cb = 0; cb < 5; ++cb) acc[rb][cb] = (f32x4){0.f, 0.f, 0.f, 0.f};
    const bf16_t* ap = X1G + (size_t)(row0 + fr) * X1GLD + wave * 256 + fq * 8;
    const bf16_t* bp = WrT + (size_t)fr * DM + wave * 256 + fq * 8;
#pragma unroll 2
    for (int ks = 0; ks < 8; ++ks) {
        bf16x8 a[2], b[5];
#pragma unroll
        for (int rb = 0; rb < 2; ++rb) a[rb] = *(const bf16x8*)(ap + (size_t)rb * 16 * X1GLD + ks * 32);
#pragma unroll
        for (int cb = 0; cb < 5; ++cb) b[cb] = *(const bf16x8*)(bp + (size_t)cb * 16 * DM + ks * 32);
#pragma unroll
        for (int rb = 0; rb < 2; ++rb)
#pragma unroll
            for (int cb = 0; cb < 5; ++cb) acc[rb][cb] = __builtin_amdgcn_mfma_f32_16x16x32_bf16(a[rb], b[cb], acc[rb][cb], 0, 0, 0);
    }
    __syncthreads();
#pragma unroll
    for (int rb = 0; rb < 2; ++rb)
#pragma unroll
        for (int cb = 0; cb < 5; ++cb)
#pragma unroll
            for (int i = 0; i < 4; ++i) red[(wave * 32 + rb * 16 + 4 * fq + i) * NRT + cb * 16 + fr] = acc[rb][cb][i];
    if (tid < 32) {
        float ss = 0.f;
        for (int i = 0; i < 32; ++i) ss += SSP[(size_t)i * SEQ + row0 + tid];
        const float rstd = rsqrtf(ss * (1.f / DM) + 1e-6f);
        RSTD2[row0 + tid] = rstd; rsl[tid] = rstd;
    }
    __syncthreads();
    for (int idx = tid; idx < 32 * NRT; idx += NTHR) {
        float s = 0.f;
#pragma unroll
        for (int w = 0; w < NWAVES; ++w) s += red[w * 32 * NRT + idx];
        lg[idx] = s;
    }
    __syncthreads();
    if (tid < 32) {
        const int t = row0 + tid; const float rstd = rsl[tid]; const LAS float* L = lg + tid * NRT;
        const float* bg = P->b_group; const float* be = P->b_er;
        float gmax = -INFINITY; int grp = 0; float glv[NG];
#pragma unroll
        for (int g = 0; g < NG; ++g) { glv[g] = L[g] * rstd + bg[g]; if (glv[g] > gmax) { gmax = glv[g]; grp = g; } }
        float sum = 0.f;
#pragma unroll
        for (int g = 0; g < NG; ++g) sum += __expf(glv[g] - gmax);
        const float pgrp = 1.f / sum;
        float v0 = -INFINITY, v1 = -INFINITY; int i0 = 0, i1 = 0;
        for (int i = 0; i < EPG; ++i) {
            const float v = L[NG + grp * EPG + i] * rstd + be[grp * EPG + i];
            if (v > v0) { v1 = v0; i1 = i0; v0 = v; i0 = i; } else if (v > v1) { v1 = v; i1 = i; }
        }
        const float e1 = __expf(v1 - v0), inv = 1.f / (1.f + e1);
        const int ea = grp * EPG + i0, eb = grp * EPG + i1;
        float* lrs = (float*)(ws + WS_LRS);
        const int sa = atomicAdd(&cnt[ea], 1); ltk[ea * LCAP + sa] = t * 2 + 0; lgt[ea * LCAP + sa] = inv * pgrp; lrs[ea * LCAP + sa] = rstd;
        const int sb = atomicAdd(&cnt[eb], 1); ltk[eb * LCAP + sb] = t * 2 + 1; lgt[eb * LCAP + sb] = e1 * inv * pgrp; lrs[eb * LCAP + sb] = rstd;
    }
}

constexpr int LDS_TAB = 131072;
constexpr int LDS_MISC = 131072 + 4096;
__device__ __forceinline__ void moe_build_table(CParams P, LAS unsigned char* lds) {
    LAS int* tab = (LAS int*)(lds + LDS_TAB);
    __syncthreads();
    if (threadIdx.x < 64) {
        const int e = threadIdx.x;
        int* cnt = (int*)(P->ws + WS_CTL + CTL_CNT);
        const int c = __hip_atomic_load(cnt + e, __ATOMIC_RELAXED, __HIP_MEMORY_SCOPE_AGENT);
        const int n = (c + MTR - 1) / MTR;
        int ts = n, os = c;
#pragma unroll
        for (int o = 1; o < 64; o <<= 1) { const int a_ = __shfl_up(ts, o), b_ = __shfl_up(os, o); if (e >= o) { ts += a_; os += b_; } }
        tab[g8::TAB_TS + e] = ts - n; tab[g8::TAB_OS + e] = os - c; tab[g8::TAB_CN + e] = c;
        if (e == 63) { tab[g8::TAB_TS + NE] = ts; tab[g8::TAB_OS + NE] = os; }
        for (int m = 0; m < n; ++m) tab[g8::TAB_TI + (ts - n) + m] = (e << 8) | m;
    }
    __syncthreads();
}

namespace m9 {
constexpr int SLOT = 16384;
#define M9_BAR() do { asm volatile("s_waitcnt lgkmcnt(0)" ::: "memory"); __builtin_amdgcn_s_barrier(); asm volatile("" ::: "memory"); } while (0)
template <bool DOWN>
__device__ __forceinline__ void moe_phase(CParams P, int vcu, int G, LAS unsigned char* lds) {
    const int tid = threadIdx.x, wid = __builtin_amdgcn_readfirstlane(tid >> 6), lane = tid & 63, fr = lane & 15, fq = lane >> 4;
    const LAS int* tab = (const LAS int*)(lds + LDS_TAB);
    unsigned char* ws = P->ws;
    constexpr int NT = DOWN ? 16 : 8, K = DOWN ? DE : DM, NKT = K / 64, ldb = DOWN ? DM : DE;
    static_assert(NKT % 2 == 0, "K-tiles are walked two at a time");
    const int nunits = tab[g8::TAB_TS + NE] * NT;
    const int* ltk = (const int*)(ws + WS_LTK);
    const int nq = lane & 31, k4g = wid * 2 + (lane >> 5);
    const int tq = fr >> 2, tp = fr & 3;
    const int rrow = (8 * fq + tq) * 256 + 8 * tp, thx = (tq + 4 * (fq & 1)) << 5;
    const char* Ab = (const char*)ws + (DOWN ? WS_HM : WS_X1G);
    int col0;
    if (DOWN) col0 = 4 * nq; else { const int g = nq >> 4, hc = 4 * (nq & 15); col0 = 32 * (hc >> 4) + 16 * g + (hc & 15); }
    int bw[4];
#pragma unroll
    for (int j = 0; j < 4; ++j) bw[j] = (4 * k4g + j) * 256 + ((2 * col0) ^ ((j + 4 * ((k4g >> 1) & 1)) << 5));
#define M9_DECODE(L_, e_, mt_, nt_, ce_, ob_) do { const int T_ = (L_) / NT; nt_ = (L_) % NT; const int ti_ = __builtin_amdgcn_readfirstlane(tab[g8::TAB_TI + T_]); e_ = ti_ >> 8; mt_ = ti_ & 255; \
        ce_ = __builtin_amdgcn_readfirstlane(tab[g8::TAB_CN + e_]); ob_ = __builtin_amdgcn_readfirstlane(tab[g8::TAB_OS + e_]); } while (0)
#define M9_BPTR(dst, e_, nt_) do { if (DOWN) dst = P->w_down + (size_t)(e_) * DE * DM + (size_t)(4 * k4g) * DM + 128 * (nt_) + 4 * nq; \
        else { const int g_ = nq >> 4, hc_ = 4 * (nq & 15); dst = (g_ ? P->w_up : P->w_gate) + (size_t)(e_) * DM * DE + (size_t)(4 * k4g) * DE + 64 * (nt_) + hc_; } } while (0)
#define M9_IDX(m_, mt_, ce_) ({ int i_ = (mt_) * MTR + 16 * (wid + 8 * (m_)) + fr; i_ < (ce_) ? i_ : (ce_) - 1; })
#define M9_OFF(raw_) ((DOWN ? (unsigned)(raw_) * (unsigned)(DE * 2) : (unsigned)((raw_) >> 1) * (unsigned)(X1GLD * 2)) + (unsigned)fq * 16u)
#define M9_RAW(m_, e_, mt_, ce_, ob_) (DOWN ? (ob_) + M9_IDX(m_, mt_, ce_) : ltk[(e_) * LCAP + M9_IDX(m_, mt_, ce_)])
    int L = vcu;
    if (L >= nunits) return;
    int e, mt, nt, ce, ob; M9_DECODE(L, e, mt, nt, ce, ob);
    const float* Bp; M9_BPTR(Bp, e, nt);
    unsigned aro[3];
#pragma unroll
    for (int m = 0; m < 3; ++m) aro[m] = M9_OFF(M9_RAW(m, e, mt, ce, ob));
    f32x4 acc[3][8];
#pragma unroll
    for (int m = 0; m < 3; ++m)
#pragma unroll
        for (int n = 0; n < 8; ++n) acc[m][n] = (f32x4){0.f, 0.f, 0.f, 0.f};
    f32x4 rb[2][4]; bf16x8 A0[3][2], A1[3][2];
    const float* Bn = Bp;
#define M9_BLOAD(set, t) do { const int t_ = (t); const float* s_ = t_ < NKT ? Bp + (size_t)t_ * (64 * ldb) : Bn + (size_t)(t_ - NKT) * (64 * ldb); \
        _Pragma("unroll") for (int j_ = 0; j_ < 4; ++j_) rb[set][j_] = *(const f32x4*)(s_ + (size_t)j_ * ldb); } while (0)
#define M9_BWRITE(set, sl) do { LAS unsigned char* d_ = lds + (sl) * SLOT; _Pragma("unroll") for (int j_ = 0; j_ < 4; ++j_) { v2u x_; \
        x_.x = g8::cvt_pk_bf16(rb[set][j_][0], rb[set][j_][1]); x_.y = g8::cvt_pk_bf16(rb[set][j_][2], rb[set][j_][3]); *(LAS v2u*)(d_ + bw[j_]) = x_; } } while (0)
#define M9_ALOAD(dst, t) do { const int t_ = (t); const unsigned to_ = (unsigned)(t_ < NKT ? t_ : t_ - NKT) * 128u; _Pragma("unroll") for (int m_ = 0; m_ < 3; ++m_) _Pragma("unroll") for (int k_ = 0; k_ < 2; ++k_) \
        dst[m_][k_] = *(const bf16x8*)(Ab + aro[m_] + to_ + k_ * 64); } while (0)
#define M9_BFRAG(dst, sl, nb_, ks_) do { const LAS unsigned char* p_ = lds + (sl) * SLOT + (rrow + (((nb_) << 5) ^ thx)) + (ks_) * 8192; \
        const v4i16_t lo_ = __builtin_amdgcn_ds_read_tr16_b64_v4i16((LAS v4i16_t*)p_); const v4i16_t hi_ = __builtin_amdgcn_ds_read_tr16_b64_v4i16((LAS v4i16_t*)(p_ + 1024)); \
        dst = (bf16x8){lo_[0], lo_[1], lo_[2], lo_[3], hi_[0], hi_[1], hi_[2], hi_[3]}; } while (0)
#define M9_COMPUTE(Acur, sl) do { _Pragma("unroll") for (int nb_ = 0; nb_ < 8; ++nb_) { bf16x8 b0_, b1_; M9_BFRAG(b0_, sl, nb_, 0); M9_BFRAG(b1_, sl, nb_, 1); \
        _Pragma("unroll") for (int m_ = 0; m_ < 2; ++m_) { acc[m_][nb_] = __builtin_amdgcn_mfma_f32_16x16x32_bf16(b0_, Acur[m_][0], acc[m_][nb_], 0, 0, 0); \
            acc[m_][nb_] = __builtin_amdgcn_mfma_f32_16x16x32_bf16(b1_, Acur[m_][1], acc[m_][nb_], 0, 0, 0); } \
        if (three) { acc[2][nb_] = __builtin_amdgcn_mfma_f32_16x16x32_bf16(b0_, Acur[2][0], acc[2][nb_], 0, 0, 0); \
            acc[2][nb_] = __builtin_amdgcn_mfma_f32_16x16x32_bf16(b1_, Acur[2][1], acc[2][nb_], 0, 0, 0); } } } while (0)
    M9_BLOAD(0, 0); M9_ALOAD(A0, 0); M9_BLOAD(1, 1);
    M9_BWRITE(0, 0);
    M9_BLOAD(0, 2);
    M9_BAR();
    for (;;) {
        const bool three = 16 * (wid + 16) < min(ce - mt * MTR, MTR);
        const int Ln = L + G; const bool has_next = Ln < nunits;
        int e2, mt2, nt2, ce2, ob2; M9_DECODE(has_next ? Ln : L, e2, mt2, nt2, ce2, ob2);
        M9_BPTR(Bn, e2, nt2);
        int rtn[3]; float eg[3]; int etk[3];
#pragma unroll
        for (int m = 0; m < 3; ++m) {
            const int i1 = M9_IDX(m, mt, ce);
            rtn[m] = M9_RAW(m, e2, mt2, ce2, ob2);
            if (DOWN) { etk[m] = ltk[e * LCAP + i1]; eg[m] = ((const float*)(ws + WS_LGT))[e * LCAP + i1]; }
            else { etk[m] = 0; eg[m] = ((const float*)(ws + WS_LRS))[e * LCAP + i1]; }
        }
#pragma unroll 1
        for (int t2 = 0; t2 < NKT; t2 += 2) {
            M9_ALOAD(A1, t2 + 1); M9_BWRITE(1, 1); M9_BLOAD(1, t2 + 3); __builtin_amdgcn_sched_barrier(0); M9_COMPUTE(A0, 0); M9_BAR();
            if (t2 == NKT - 2) {
#pragma unroll
                for (int m = 0; m < 3; ++m) aro[m] = M9_OFF(rtn[m]);
            }
            M9_ALOAD(A0, t2 + 2); M9_BWRITE(0, 0); M9_BLOAD(0, t2 + 4); __builtin_amdgcn_sched_barrier(0); M9_COMPUTE(A1, 1); M9_BAR();
        }
#pragma unroll
        for (int m = 0; m < 3; ++m) {
            const int idx = mt * MTR + 16 * (wid + 8 * m) + fr;
            if (idx < ce) {
                if (DOWN) {
                    bf16_t* rowp = (bf16_t*)(ws + WS_Y) + (size_t)etk[m] * DM + nt * 128 + 4 * fq;
#pragma unroll
                    for (int n = 0; n < 8; ++n) { const f32x4 v = acc[m][n] * eg[m]; v2u w; w.x = g8::cvt_pk_bf16(v[0], v[1]); w.y = g8::cvt_pk_bf16(v[2], v[3]); *(v2u*)(rowp + 16 * n) = w; }
                } else {
                    bf16_t* rowp = (bf16_t*)(ws + WS_HM) + (size_t)(ob + idx) * DE + nt * 64 + 4 * fq; const float rs = eg[m];
#pragma unroll
                    for (int j = 0; j < 4; ++j) {
                        float h[4];
#pragma unroll
                        for (int i = 0; i < 4; ++i) { const float g = acc[m][2 * j][i] * rs, uu = acc[m][2 * j + 1][i] * rs; h[i] = g * __builtin_amdgcn_rcpf(1.f + __expf(-g)) * uu; }
                        v2u w; w.x = g8::cvt_pk_bf16(h[0], h[1]); w.y = g8::cvt_pk_bf16(h[2], h[3]);
                        *(v2u*)(rowp + 16 * j) = w;
                    }
                }
            }
        }
        if (!has_next) break;
        L = Ln; e = e2; mt = mt2; nt = nt2; ce = ce2; ob = ob2; Bp = Bn;
#pragma unroll
        for (int m = 0; m < 3; ++m)
#pragma unroll
            for (int n = 0; n < 8; ++n) acc[m][n] = (f32x4){0.f, 0.f, 0.f, 0.f};
    }
#undef M9_IDX
#undef M9_OFF
#undef M9_RAW
#undef M9_DECODE
#undef M9_BPTR
#undef M9_BLOAD
#undef M9_BWRITE
#undef M9_ALOAD
#undef M9_BFRAG
#undef M9_COMPUTE
}
#undef M9_BAR
}
constexpr int LDS_BYTES = 147456;
__global__ void __launch_bounds__(NTHR, 2) mega(Params p_kernarg) {
    extern __shared__ __attribute__((aligned(16))) unsigned char lds_raw[];
    LAS unsigned char* lds = (LAS unsigned char*)lds_raw;
    const int G = gridDim.x, bx = blockIdx.x;
    const int vcu = (G % 8 == 0) ? (bx % 8) * (G / 8) + bx / 8 : bx;
    CParams P = kparams();
    const int lo = P->ph_lo, hi = P->ph_hi;
#define IN(k) (lo <= (k) && (k) < hi)
#define BOTH(k) (IN(k) && IN((k) + 1))
    volatile LAS unsigned* misc = (volatile LAS unsigned*)(lds + LDS_MISC);
    if (threadIdx.x < 32) misc[threadIdx.x] = 0u;
    __syncthreads();
    XcdBarrier bar; bar.bar = (unsigned*)(P->ws + WS_CTL) + P->li * XCD_BAR_WORDS; bar.x = 0; bar.st = misc + 8;
    if (hi - lo > 1) bar = xcd_barrier_post(bar.bar, misc + 8);
#define GRID_BAR(k) do { if (BOTH(k)) xcd_barrier(bar); } while (0)
#define REPS(k) for (int rep_ = 0; rep_ < ((REP_PHASE == (k)) ? 2 : 1); ++rep_)
    if (IN(0)) REPS(0) { phase_prologue(kparams(), vcu, G, lds); GRID_BAR(0); }
    if (IN(1)) REPS(1) {
        g8::DenseOrder S; S.init(P->ws + WS_HB, P->ws + WS_WINT, SEQ, DIN, DM, G, bx);
        g8::EpiIn E{P};
        g8::gemm_phase<g8::EpiIn, g8::DenseOrder, false>(lds, DM, (size_t)g8::HALF * DM * 2, (size_t)g8::HALF * DM * 2, S, E);
        GRID_BAR(1);
    }
    if (IN(2)) REPS(2) {
        for (int r_ = 0; r_ < (REP_PHASE == 20 ? 2 : 1); ++r_) for (int u = vcu; u < NH * (SEQ / 512); u += G) attn_unit(kparams(), u >> 4, u & 15, lds);
        for (int r_ = 0; r_ < (REP_PHASE == 21 ? 2 : 1); ++r_) for (int it = vcu; it < SEQ / CONV_T; it += G) conv_item(kparams(), it, lds);
        GRID_BAR(2);
    }
    if (IN(3)) REPS(3) {
        g8::DenseOrder S; S.init(P->ws + WS_MIX, P->ws + WS_WOUTT, SEQ, DM, DM, G, bx);
        g8::EpiOut E{P};
        g8::gemm_phase<g8::EpiOut, g8::DenseOrder, false>(lds, DM, (size_t)g8::HALF * DM * 2, (size_t)g8::HALF * DM * 2, S, E);
        GRID_BAR(3);
    }
    if (IN(4)) {
        for (int it = vcu; it < SEQ / 32; it += G) router_item(kparams(), it, lds);
        GRID_BAR(4);
    }
    if (IN(5)) REPS(5) { moe_build_table(kparams(), lds); m9::moe_phase<false>(kparams(), vcu, G, lds); GRID_BAR(5); }
    if (IN(6)) REPS(6) { moe_build_table(kparams(), lds); m9::moe_phase<true>(kparams(), vcu, G, lds); GRID_BAR(6); }
    if (IN(7)) REPS(7) phase_final(kparams(), vcu, G);
#undef REPS
#undef IN
#undef BOTH
#undef GRID_BAR
}

extern "C" void kernel_launch(void* const* d_in, const int* in_sizes, int n_in, void* d_out, int out_size, void* d_ws, size_t ws_size, hipStream_t stream) {
    static int grid = 0;
    if (grid == 0) {
        if (ws_size < WS_END) { fprintf(stderr, "kernel_launch: workspace too small (%zu < %zu)\n", ws_size, (size_t)WS_END); grid = -1; return; }
        int dev = 0, cus = 0, per_cu = 0;
        (void)hipGetDevice(&dev); (void)hipDeviceGetAttribute(&cus, hipDeviceAttributeMultiprocessorCount, dev);
        (void)hipFuncSetAttribute((const void*)mega, hipFuncAttributeMaxDynamicSharedMemorySize, LDS_BYTES);
        (void)hipOccupancyMaxActiveBlocksPerMultiprocessor(&per_cu, (const void*)mega, NTHR, LDS_BYTES);
        if (per_cu < 1) { fprintf(stderr, "kernel_launch: occupancy query says %d blocks per CU\n", per_cu); grid = -1; return; }
        grid = cus;
    }
    if (grid < 0) return;
    Params p{};
    p.x = (const float*)d_in[0]; p.norm1_g = (const float*)d_in[1]; p.w_in = (const float*)d_in[2]; p.w_dw = (const float*)d_in[3]; p.b_dw = (const float*)d_in[4];
    p.ln_g = (const float*)d_in[5]; p.ln_b = (const float*)d_in[6]; p.rel_bias = (const float*)d_in[7]; p.w_out = (const float*)d_in[8]; p.norm2_g = (const float*)d_in[9];
    p.w_group = (const float*)d_in[10]; p.b_group = (const float*)d_in[11]; p.w_er = (const float*)d_in[12]; p.b_er = (const float*)d_in[13];
    p.w_gate = (const float*)d_in[14]; p.w_up = (const float*)d_in[15]; p.w_down = (const float*)d_in[16]; p.final_g = (const float*)d_in[17];
    p.out = (float*)d_out; p.ws = (unsigned char*)d_ws;
    unsigned char* ws = (unsigned char*)d_ws;
    (void)hipMemsetAsync(ws + WS_CTL, 0, CTL_BYTES, stream);
    p.ph_lo = 0; p.ph_hi = 8; p.li = 0; p.pad = 0;
    hipLaunchKernelGGL(mega, dim3(grid), dim3(NTHR), LDS_BYTES, stream, p);
}
```

```cpp
#include <hip/hip_runtime.h>
#include <stdint.h>
#include <cstdio>

#ifndef PROBE_MOE
#define PROBE_MOE 0
#endif
#ifndef SWATCH
#define SWATCH 0
#endif
#ifndef SW_BLOCK
#define SW_BLOCK 0
#endif
#ifndef REP_PHASE
#define REP_PHASE -1
#endif

#define LAS __attribute__((address_space(3)))
#define GAS __attribute__((address_space(1)))
typedef unsigned short bf16_t;
typedef unsigned v4u __attribute__((ext_vector_type(4)));
typedef unsigned v2u __attribute__((ext_vector_type(2)));
typedef float f32x4 __attribute__((ext_vector_type(4)));
typedef float f32x16 __attribute__((ext_vector_type(16)));
typedef short bf16x8 __attribute__((ext_vector_type(8)));

constexpr int DM = 2048, SEQ = 8192, DCONV = 1024, DATT = 1024, HD = 64, NH = 16, DIN = 5120;
constexpr int CHUNK = 64, LEFT = 8, RCLIP = 128, NREL = 257, CW = 31;
constexpr int NG = 8, EPG = 8, NE = 64, DE = 512;
constexpr int LCAP = 8192;
constexpr int MTR = 384;
constexpr int NWAVES = 8, NTHR = 512;
constexpr int LDS_TAB = 131072;
constexpr int LDS_MISC = 131072 + 4096;
constexpr float LOG2E = 1.4426950408889634f;
constexpr float QSCALE = 0.125f * LOG2E;
constexpr int X1GLD = DM + 64;
constexpr int NRT = 80;

constexpr size_t MiB = 1ull << 20;
constexpr size_t WS_CTL = 0, CTL_BYTES = 1 * MiB;
constexpr size_t CTL_CNT = 524288;
constexpr int CNT_STRIDE = 64;
constexpr size_t CTL_UPAN = 600000 / 256 * 256;
constexpr size_t CTL_CONVQ = CTL_UPAN + 64 * 256;
constexpr size_t WS_LTK = 1 * MiB, WS_LGT = 3 * MiB, WS_RSTD2 = 5 * MiB, WS_SSP = 6 * MiB, WS_WRT = 7 * MiB;
constexpr size_t WS_WINT = 8 * MiB, WS_WOUTT = 28 * MiB, WS_HB = 36 * MiB, WS_U = 68 * MiB;
constexpr size_t WS_QH = 84 * MiB, WS_KH = 100 * MiB, WS_VH = 116 * MiB, WS_MIX = 132 * MiB;
constexpr size_t WS_X1 = 164 * MiB, WS_X1G = 344 * MiB  , WS_HM = 260 * MiB, WS_Y = 280 * MiB;
constexpr size_t WS_LRS = 384 * MiB;
constexpr size_t WS_END = 386 * MiB;

struct Params {
    const float *x, *norm1_g, *w_in, *w_dw, *b_dw, *ln_g, *ln_b, *rel_bias, *w_out, *norm2_g, *w_group, *b_group, *w_er, *b_er, *w_gate, *w_up, *w_down, *final_g;
    float* out; unsigned char* ws;
    int ph_lo, ph_hi, li, pad;
};

typedef const __attribute__((address_space(4))) Params* CParams;
__device__ __forceinline__ CParams kparams() { CParams kp = (CParams)__builtin_amdgcn_kernarg_segment_ptr(); asm volatile("" : "+s"(kp)); return kp; }
__device__ __forceinline__ CParams relaunder(CParams kp) { asm volatile("" : "+s"(kp)); return kp; }

__device__ __forceinline__ float bf2f(unsigned b) { return __uint_as_float(b << 16); }
__device__ __forceinline__ unsigned f2bf(float f) { unsigned u = __float_as_uint(f); return (u + 0x7fffu + ((u >> 16) & 1u)) >> 16; }
__device__ __forceinline__ unsigned pk2(float lo, float hi) { return f2bf(lo) | (f2bf(hi) << 16); }
__device__ __forceinline__ float wave_sum(float v) {
#pragma unroll
    for (int o = 1; o < 64; o <<= 1) v += __shfl_xor(v, o);
    return v;
}
__device__ __forceinline__ float wave_max(float v) {
#pragma unroll
    for (int o = 1; o < 64; o <<= 1) v = fmaxf(v, __shfl_xor(v, o));
    return v;
}
__device__ __forceinline__ float sigmoidf_(float x) { return 1.f / (1.f + __expf(-x)); }
__host__ __device__ __forceinline__ int wint_row(int n) {
    if (n < 1024) return 256 * (n >> 7) + (n & 127);
    if (n < 2048) { const int m = n - 1024; return 256 * (m >> 7) + 128 + (m & 127); }
    return n;
}

__device__ __forceinline__ void p0_transpose_item(const float* W, int ldw, int k0, int n0, bf16_t* WT, int K, int orow0, LAS float* scr, int lane) {
#pragma unroll 8
    for (int i = 0; i < 32; ++i) { const int kk = 2 * i + (lane >> 5); scr[kk * 33 + (lane & 31)] = W[(size_t)(k0 + kk) * ldw + n0 + (lane & 31)]; }
    asm volatile("s_waitcnt lgkmcnt(0)" ::: "memory");
    const int c = lane & 7;
#pragma unroll
    for (int j = 0; j < 4; ++j) { const int n = (lane >> 3) + 8 * j; const LAS float* s = scr + (8 * c) * 33 + n;
        v4u o; o.x = pk2(s[0 * 33], s[1 * 33]); o.y = pk2(s[2 * 33], s[3 * 33]); o.z = pk2(s[4 * 33], s[5 * 33]); o.w = pk2(s[6 * 33], s[7 * 33]);
        *(v4u*)(WT + (size_t)(orow0 + n) * K + k0 + 8 * c) = o; }
    asm volatile("s_waitcnt lgkmcnt(0)" ::: "memory");
}

__device__ __forceinline__ void phase_prologue(CParams P, int vcu, int G, LAS unsigned char* lds) {
    const int tid = threadIdx.x, lane = tid & 63, wave = __builtin_amdgcn_readfirstlane(tid >> 6);
    LAS float* scr = (LAS float*)(lds + wave * 16384);
    const int gw = vcu * NWAVES + wave, NGW = G * NWAVES;
    bf16_t* WinT = (bf16_t*)(P->ws + WS_WINT); bf16_t* WoutT = (bf16_t*)(P->ws + WS_WOUTT); bf16_t* WrT = (bf16_t*)(P->ws + WS_WRT);
    bf16_t* Hb = (bf16_t*)(P->ws + WS_HB);
    for (int m = gw; m < SEQ; m += NGW) {
        const f32x4* xr = (const f32x4*)(P->x + (size_t)m * DM) + lane; const f32x4* gr = (const f32x4*)P->norm1_g + lane;
        f32x4 v[8]; float s = 0.f;
#pragma unroll
        for (int j = 0; j < 8; ++j) { v[j] = xr[64 * j]; s += (v[j].x * v[j].x + v[j].y * v[j].y) + (v[j].z * v[j].z + v[j].w * v[j].w); }
        const float rstd = rsqrtf(wave_sum(s) * (1.f / DM) + 1e-6f);
        v2u* o8 = (v2u*)(Hb + (size_t)m * DM) + lane;
#pragma unroll
        for (int j = 0; j < 8; ++j) { const f32x4 g = gr[64 * j]; v2u o; o.x = pk2(v[j].x * rstd * g.x, v[j].y * rstd * g.y); o.y = pk2(v[j].z * rstd * g.z, v[j].w * rstd * g.w); o8[64 * j] = o; }
    }
    constexpr int I_IN = (DM / 64) * (DIN / 32), I_OUT = (DM / 64) * (DM / 32);
    constexpr int NITEMS = I_IN + I_OUT;
    for (int it = gw; it < NITEMS; it += NGW) {
        int r = it;
        if (r < I_IN) { const int nb = r % (DIN / 32), kb = r / (DIN / 32); p0_transpose_item(P->w_in, DIN, 64 * kb, 32 * nb, WinT, DM, wint_row(32 * nb), scr, lane); continue; } r -= I_IN;
        { const int nb = r % (DM / 32), kb = r / (DM / 32); p0_transpose_item(P->w_out, DM, 64 * kb, 32 * nb, WoutT, DM, 32 * nb, scr, lane); }
    }
    for (int idx = (vcu * NTHR + tid); idx < NRT * DM; idx += G * NTHR) {
        const int n = idx / DM, k = idx % DM;
        float v = 0.f; if (n < NG) v = P->w_group[k * NG + n]; else if (n < NG + NE) v = P->w_er[k * NE + (n - NG)];
        WrT[idx] = (bf16_t)f2bf(v);
    }
}

__device__ __forceinline__ void conv_queue(CParams P, LAS unsigned char* lds);
constexpr int CONV_T = 16, CONV_ROWS = CONV_T + CW - 1;
constexpr int CONV_LDS_RED = 96 * 1024;
__device__ __forceinline__ void conv_item(CParams P, int item, LAS unsigned char* lds) {
    const int tid = threadIdx.x, lane = tid & 63, wave = tid >> 6;
    const bf16_t* U = (const bf16_t*)(P->ws + WS_U); bf16_t* MIX = (bf16_t*)(P->ws + WS_MIX);
    const int t0 = item * CONV_T;
    __syncthreads();
    for (int idx = tid; idx < CONV_ROWS * 128; idx += NTHR) {
        const int r = idx >> 7, ch = idx & 127, t = t0 - (CW - 1) + r;
        v4u v = {0u, 0u, 0u, 0u}; if (t >= 0) v = *(const v4u*)(U + (size_t)t * DCONV + ch * 8);
        *(LAS v4u*)(lds + r * 2048 + ch * 16) = v;
    }
    float w0[CW], w1[CW];
#pragma unroll
    for (int j = 0; j < CW; ++j) { const float2 w = *(const float2*)(P->w_dw + j * DCONV + 2 * tid); w0[j] = w.x; w1[j] = w.y; }
    const float2 bb = *(const float2*)(P->b_dw + 2 * tid);
    float a0[CONV_T], a1[CONV_T];
#pragma unroll
    for (int t = 0; t < CONV_T; ++t) { a0[t] = bb.x; a1[t] = bb.y; }
    __syncthreads();
#pragma unroll
    for (int r = 0; r < CONV_ROWS; ++r) {
        const unsigned u2 = *(const LAS unsigned*)(lds + r * 2048 + tid * 4);
        const float ua = bf2f(u2 & 0xffffu), ub = bf2f(u2 >> 16);
#pragma unroll
        for (int t = 0; t < CONV_T; ++t) { const int j = r - t; if (j >= 0 && j < CW) { a0[t] += w0[j] * ua; a1[t] += w1[j] * ub; } }
    }
    LAS float* red = (LAS float*)(lds + CONV_LDS_RED);
    LAS float* st = red + NWAVES * CONV_T * 2;
#pragma unroll
    for (int t = 0; t < CONV_T; ++t) {
        const float s = wave_sum(a0[t] + a1[t]), q = wave_sum(a0[t] * a0[t] + a1[t] * a1[t]);
        if (lane == 0) { red[(wave * CONV_T + t) * 2] = s; red[(wave * CONV_T + t) * 2 + 1] = q; }
    }
    __syncthreads();
    if (tid < CONV_T) {
        float s = 0.f, q = 0.f;
        for (int w = 0; w < NWAVES; ++w) { s += red[(w * CONV_T + tid) * 2]; q += red[(w * CONV_T + tid) * 2 + 1]; }
        const float mu = s * (1.f / DCONV), var = fmaxf(q * (1.f / DCONV) - mu * mu, 0.f);
        st[tid * 2] = mu; st[tid * 2 + 1] = rsqrtf(var + 1e-5f);
    }
    __syncthreads();
    const float2 lg = *(const float2*)(P->ln_g + 2 * tid), lb = *(const float2*)(P->ln_b + 2 * tid);
#pragma unroll
    for (int t = 0; t < CONV_T; ++t) {
        const float mu = st[t * 2], rs = st[t * 2 + 1];
        const float u0 = (a0[t] - mu) * rs * lg.x + lb.x, u1 = (a1[t] - mu) * rs * lg.y + lb.y;
        *(unsigned*)(MIX + (size_t)(t0 + t) * DM + 2 * tid) = pk2(u0 * sigmoidf_(u0), u1 * sigmoidf_(u1));
    }
}

__device__ __forceinline__ void conv_queue(CParams P, LAS unsigned char* lds) {
    unsigned char* ws = P->ws;
    unsigned* upan = (unsigned*)(ws + WS_CTL + CTL_UPAN); unsigned* head = (unsigned*)(ws + WS_CTL + CTL_CONVQ);
    volatile LAS int* slot = (volatile LAS int*)(lds + LDS_MISC + 64);
    for (;;) {
        __syncthreads();
        if (threadIdx.x < 64) {
            int item = 0;
            if (threadIdx.x == 0) item = (int)__hip_atomic_fetch_add(head, 1u, __ATOMIC_RELAXED, __HIP_MEMORY_SCOPE_AGENT);
            item = __builtin_amdgcn_readfirstlane(item);
            if (item < SEQ / CONV_T) {
                const int t0 = item * CONV_T, pa = (t0 >= CW - 1 ? t0 - (CW - 1) : 0) >> 8, pb = (t0 + CONV_T - 1) >> 8;
                unsigned spins = 0;
                while ((unsigned)__builtin_amdgcn_readfirstlane(__hip_atomic_load(upan + 64 * pa, __ATOMIC_RELAXED, __HIP_MEMORY_SCOPE_AGENT)) < 64u ||
                       (unsigned)__builtin_amdgcn_readfirstlane(__hip_atomic_load(upan + 64 * pb, __ATOMIC_RELAXED, __HIP_MEMORY_SCOPE_AGENT)) < 64u) {
                    __builtin_amdgcn_s_sleep(8); if (++spins > (1u << 22)) break;
                }
                __builtin_amdgcn_fence(__ATOMIC_ACQUIRE, "agent");
                asm volatile("s_waitcnt vmcnt(0)" ::: "memory");
            }
            if (threadIdx.x == 0) slot[0] = item;
        }
        __syncthreads();
        const int item = slot[0];
        if (item >= SEQ / CONV_T) break;
        conv_item(P, item, lds);
    }
}

__device__ __forceinline__ void phase_final(CParams P, int vcu, int G) {
    const int tid = threadIdx.x, lane = tid & 63, wave = tid >> 6;
    const bf16_t* X1 = (const bf16_t*)(P->ws + WS_X1); const bf16_t* Y = (const bf16_t*)(P->ws + WS_Y);
    for (int m = vcu * NWAVES + wave; m < SEQ; m += G * NWAVES) {
        const v2u* xr = (const v2u*)(X1 + (size_t)m * DM) + lane;
        const v2u* y0 = (const v2u*)(Y + (size_t)(2 * m) * DM) + lane; const v2u* y1 = (const v2u*)(Y + (size_t)(2 * m + 1) * DM) + lane;
        f32x4 v[8]; float s = 0.f;
#pragma unroll
        for (int j = 0; j < 8; ++j) {
            { const v2u xv = xr[64 * j]; v[j] = (f32x4){bf2f(xv.x & 0xffffu), bf2f(xv.x >> 16), bf2f(xv.y & 0xffffu), bf2f(xv.y >> 16)}; } const v2u a = y0[64 * j], b = y1[64 * j];
            v[j].x += bf2f(a.x & 0xffffu) + bf2f(b.x & 0xffffu); v[j].y += bf2f(a.x >> 16) + bf2f(b.x >> 16);
            v[j].z += bf2f(a.y & 0xffffu) + bf2f(b.y & 0xffffu); v[j].w += bf2f(a.y >> 16) + bf2f(b.y >> 16);
            s += (v[j].x * v[j].x + v[j].y * v[j].y) + (v[j].z * v[j].z + v[j].w * v[j].w);
        }
        const float rstd = rsqrtf(wave_sum(s) * (1.f / DM) + 1e-6f);
        f32x4* o = (f32x4*)(P->out + (size_t)m * DM) + lane; const f32x4* g = (const f32x4*)P->final_g + lane;
#pragma unroll
        for (int j = 0; j < 8; ++j) o[64 * j] = v[j] * rstd * g[64 * j];
    }
}

namespace g8 {
constexpr int BM = 256, BK = 64, HALF = 128, HTB = HALF * BK * 2, STAGE_BYTES = 8 * HTB, NXCD = 8, WGM = 8;
__host__ __device__ __forceinline__ int lds_byte(int r, int c) { const int st = (r >> 4) * 2 + (c >> 5), rr = r & 15, cc = c & 31, ob = rr * 64 + cc * 2; return st * 1024 + (ob ^ (((ob >> 9) & 1) << 5)); }
__host__ __device__ __forceinline__ void stage_rc(int b, int& R, int& C) { const int st = b / 1024, sb = b % 1024, swz = sb ^ (((sb >> 9) & 1) << 5); R = (st >> 1) * 16 + swz / 64; C = (st & 1) * 32 + (swz % 64) / 2; }
__host__ __device__ __forceinline__ int perm32(int rho) { const int n = rho >> 4, i = rho & 15; return 8 * (i >> 2) + 4 * n + (i & 3); }
__device__ __forceinline__ unsigned cvt_pk_bf16(float lo, float hi) { unsigned r; asm volatile("v_cvt_pk_bf16_f32 %0, %1, %2" : "=v"(r) : "v"(lo), "v"(hi)); return r; }

struct Unit { const char* a; const char* b; int i0, i1, i2; };

template <class Epi, class Sched, bool GATHER>
__device__ __forceinline__ void gemm_phase(LAS unsigned char* lds, const int K, const size_t astep, const size_t bstep, const Sched& S, const Epi& E) {
    const int tid = threadIdx.x, wid = __builtin_amdgcn_readfirstlane(tid >> 6), lane = tid & 63, wr = wid >> 2, wc = wid & 3, fr = lane & 15, fq = lane >> 4;
    const int nt = K / BK;
    unsigned voffB[2], voffA0[2], voffA1[2];
#pragma unroll
    for (int i = 0; i < 2; ++i) { int R, C; stage_rc(tid * 16 + i * 8192, R, C); const int Rb = (R & ~31) + perm32(R & 31);
        voffB[i] = (unsigned)(Rb * K + C) * 2u; voffA0[i] = (unsigned)(R * K + C) * 2u; voffA1[i] = voffA0[i]; }
    const size_t kstep = (size_t)(BK * 2);
    const unsigned ldsw = (unsigned)wid * 1024u;
    const int aoff = lds_byte(wr * 64 + fr, fq * 8), boff = lds_byte(wc * 32 + fr, fq * 8);
#define G8_SA(b, h) (((b) * 2 + (h)) * HTB)
#define G8_SB(b, h) ((4 + (b) * 2 + (h)) * HTB)
#define G8_STAGE(bufoff, gbase, voff) do { _Pragma("unroll") for (int _i = 0; _i < 2; ++_i) \
        __builtin_amdgcn_global_load_lds((const unsigned*)((const char*)(gbase) + (voff)[_i]), (LAS unsigned*)(lds + (bufoff) + ldsw + _i * 8192), 16, 0, 0); } while (0)
#define G8_LDA(dst, b, h) do { _Pragma("unroll") for (int m = 0; m < 4; ++m) _Pragma("unroll") for (int k = 0; k < 2; ++k) dst[m][k] = *(const LAS bf16x8*)(lds + G8_SA(b, h) + aoff + m * 2048 + k * 1024); } while (0)
#define G8_LDB(dst, b, h) do { _Pragma("unroll") for (int n = 0; n < 2; ++n) _Pragma("unroll") for (int k = 0; k < 2; ++k) dst[n][k] = *(const LAS bf16x8*)(lds + G8_SB(b, h) + boff + n * 2048 + k * 1024); } while (0)
#define G8_MMA(ai, bj, At, Bt) do { __builtin_amdgcn_s_setprio(1); _Pragma("unroll") for (int m = 0; m < 4; ++m) _Pragma("unroll") for (int n = 0; n < 2; ++n) _Pragma("unroll") for (int k = 0; k < 2; ++k) \
        acc[ai][bj][m][n] = __builtin_amdgcn_mfma_f32_16x16x32_bf16(Bt[n][k], At[m][k], acc[ai][bj][m][n], 0, 0, 0); __builtin_amdgcn_s_setprio(0); } while (0)
#define G8_WAIT_V(n) asm volatile("s_waitcnt vmcnt(" #n ")" ::: "memory")
#define G8_WAIT_L(n) asm volatile("s_waitcnt lgkmcnt(" #n ")" ::: "memory")
#define G8_BAR __builtin_amdgcn_s_barrier()
#define G8_SCHED __builtin_amdgcn_sched_barrier(0)
#define G8_GOFF(u) do { if (GATHER) { _Pragma("unroll") for (int _i = 0; _i < 2; ++_i) { int R_, C_; stage_rc(tid * 16 + _i * 8192, R_, C_); \
        voffA0[_i] = S.row_off(u, R_) + (unsigned)C_ * 2u; voffA1[_i] = S.row_off(u, R_ + HALF) + (unsigned)C_ * 2u; } } } while (0)
    Unit cur, nxt; int ui = 0;
    if (!S.next(0, cur)) return;
    f32x4 acc[2][2][4][2];
#pragma unroll
    for (int a = 0; a < 2; ++a)
#pragma unroll
        for (int b = 0; b < 2; ++b)
#pragma unroll
            for (int m = 0; m < 4; ++m)
#pragma unroll
                for (int n = 0; n < 2; ++n) acc[a][b][m][n] = (f32x4){0.f, 0.f, 0.f, 0.f};
    bf16x8 At[4][2], B0[2][2], B1[2][2];
    const char* cA0 = cur.a; const char* cB0 = cur.b;
#define cA1 (cA0 + astep)
#define cB1 (cB0 + bstep)
    G8_GOFF(cur);
    G8_STAGE(G8_SB(0, 0), cB0, voffB); G8_STAGE(G8_SB(0, 1), cB1, voffB); G8_STAGE(G8_SA(0, 0), cA0, voffA0); G8_STAGE(G8_SA(0, 1), cA1, voffA1);
    if (wr == 1) G8_BAR;
    G8_WAIT_V(2); G8_BAR;
    G8_STAGE(G8_SB(1, 0), cB0 + kstep, voffB); G8_STAGE(G8_SA(1, 0), cA0 + kstep, voffA0); G8_STAGE(G8_SB(1, 1), cB1 + kstep, voffB);
    G8_WAIT_V(6); G8_BAR;
    for (;;) {
        const bool has_next = S.next(ui + 1, nxt);
        const char* nA0 = has_next ? nxt.a : cA0; const char* nB0 = has_next ? nxt.b : cB0;
        for (int t = 0; t < nt; t += 2) {
            const bool last = (t == nt - 2);
            const char* a1h = cA1 + (size_t)(t + 1) * kstep;
            const char* a2_0 = last ? nA0 : cA0 + (size_t)(t + 2) * kstep; const char* a2_1 = a2_0 + astep;
            const char* b2_0 = last ? nB0 : cB0 + (size_t)(t + 2) * kstep; const char* b2_1 = b2_0 + bstep;
            const char* a3_0 = a2_0 + kstep; const char* b3_0 = b2_0 + kstep; const char* b3_1 = b2_1 + kstep;
            G8_LDB(B0, 0, 0); G8_LDB(B1, 0, 1); G8_SCHED; G8_LDA(At, 0, 0); G8_STAGE(G8_SA(1, 1), a1h, voffA1);
            G8_WAIT_V(8); G8_WAIT_L(0); G8_BAR; G8_MMA(0, 0, At, B0); G8_MMA(0, 1, At, B1); G8_BAR; G8_SCHED;
            if (GATHER) { if (last && has_next) { G8_GOFF(nxt); } }
            G8_LDA(At, 0, 1); G8_STAGE(G8_SB(0, 0), b2_0, voffB); G8_STAGE(G8_SB(0, 1), b2_1, voffB); G8_STAGE(G8_SA(0, 0), a2_0, voffA0);
            G8_WAIT_V(8); G8_WAIT_L(0); G8_BAR; G8_MMA(1, 0, At, B0); G8_MMA(1, 1, At, B1); G8_BAR; G8_SCHED;
            G8_LDB(B0, 1, 0); G8_LDB(B1, 1, 1); G8_SCHED; G8_LDA(At, 1, 0); G8_STAGE(G8_SA(0, 1), a2_1, voffA1);
            G8_WAIT_V(8); G8_WAIT_L(0); G8_BAR; G8_MMA(0, 0, At, B0); G8_MMA(0, 1, At, B1); G8_BAR; G8_SCHED;
            G8_LDA(At, 1, 1); G8_STAGE(G8_SB(1, 0), b3_0, voffB); G8_STAGE(G8_SB(1, 1), b3_1, voffB); G8_STAGE(G8_SA(1, 0), a3_0, voffA0);
            G8_WAIT_V(8); G8_WAIT_L(0); G8_BAR; G8_MMA(1, 0, At, B0); G8_MMA(1, 1, At, B1); G8_BAR; G8_SCHED;
        }
        if (wr == 0) G8_BAR;
        E(acc, cur, wr, wc, fr, fq);
        if (!has_next) break;
#pragma unroll
        for (int a = 0; a < 2; ++a)
#pragma unroll
            for (int b = 0; b < 2; ++b)
#pragma unroll
                for (int m = 0; m < 4; ++m)
#pragma unroll
                    for (int n = 0; n < 2; ++n) acc[a][b][m][n] = (f32x4){0.f, 0.f, 0.f, 0.f};
        cur = nxt; cA0 = nA0; cB0 = nB0; ++ui;
        if (wr == 1) G8_BAR;
    }
    G8_WAIT_V(0);
    G8_BAR;
#undef G8_SA
#undef G8_SB
#undef G8_STAGE
#undef G8_LDA
#undef G8_LDB
#undef G8_MMA
#undef G8_WAIT_V
#undef G8_WAIT_L
#undef G8_BAR
#undef G8_SCHED
#undef G8_GOFF
#undef cA1
#undef cB1
}

struct DenseOrder {
    int nM, nN, nwg, G, c, K; const char* A; const char* Bt;
    __device__ __forceinline__ void init(const void* A_, const void* Bt_, int M, int N, int K_, int G_, int c_) { A = (const char*)A_; Bt = (const char*)Bt_; nM = M / BM; nN = N / BM; nwg = nM * nN; G = G_; c = c_; K = K_; }
    __device__ __forceinline__ bool next(int i, Unit& u) const {
        const long L = (long)i * G + c; if (L >= nwg) return false;
        int wgid = (int)L; { const int q = nwg / NXCD, r = nwg % NXCD, xcd = wgid % NXCD, off = wgid / NXCD; wgid = (xcd < r ? xcd * (q + 1) : r * (q + 1) + (xcd - r) * q) + off; }
        const int nig = WGM * nN, gid = wgid / nig, fm = gid * WGM, gsz = (nM - fm) < WGM ? (nM - fm) : WGM;
        const int pm = fm + ((wgid % nig) % gsz), pn = (wgid % nig) / gsz;
        const size_t hstep = (size_t)HALF * K * 2;
        u.a = A + (size_t)pm * 2 * hstep; u.b = Bt + (size_t)pn * 2 * hstep; u.i0 = pm; u.i1 = pn; u.i2 = 0; return true;
    }
    __device__ __forceinline__ unsigned row_off(const Unit&, int) const { return 0u; }
};

struct InOrder {
    int G, c, K; const char* A; const char* Bt;
    __device__ __forceinline__ void init(const void* A_, const void* Bt_, int K_, int G_, int c_) { A = (const char*)A_; Bt = (const char*)Bt_; G = G_; c = c_; K = K_; }
    __device__ __forceinline__ bool next(int i, Unit& u) const {
        const int L = i * G + c; if (L >= 640) return false;
        int pm, pn; if (L < 256) { pm = L >> 3; pn = L & 7; } else { const int l2 = L - 256; pm = l2 / 12; pn = 8 + l2 % 12; }
        const size_t hstep = (size_t)HALF * K * 2;
        u.a = A + (size_t)pm * 2 * hstep; u.b = Bt + (size_t)pn * 2 * hstep; u.i0 = pm; u.i1 = pn; u.i2 = 0; return true;
    }
    __device__ __forceinline__ unsigned row_off(const Unit&, int) const { return 0u; }
};

struct EpiIn {
    CParams P;
    __device__ __forceinline__ void operator()(const f32x4 (&acc)[2][2][4][2], const Unit& u, int wr, int wc, int fr, int fq) const {
        unsigned char* ws = relaunder(P)->ws;
        bf16_t* U = (bf16_t*)(ws + WS_U); bf16_t* QKV = (bf16_t*)(ws + WS_QH);
        const int pm = u.i0, pn = u.i1;
        const int row0 = pm * BM + wr * 64 + fr;
        if (pn < 8) {
            bf16_t* base = U + (size_t)row0 * DCONV + pn * 128 + wc * 32 + 8 * fq;
#pragma unroll
            for (int ai = 0; ai < 2; ++ai)
#pragma unroll
                for (int m = 0; m < 4; ++m) {
                    float r[8];
#pragma unroll
                    for (int n = 0; n < 2; ++n)
#pragma unroll
                        for (int i = 0; i < 4; ++i) { const float v = acc[ai][0][m][n][i], g = acc[ai][1][m][n][i]; r[4 * n + i] = v * __builtin_amdgcn_rcpf(1.f + __expf(-g)); }
                    v4u w; w.x = cvt_pk_bf16(r[0], r[1]); w.y = cvt_pk_bf16(r[2], r[3]); w.z = cvt_pk_bf16(r[4], r[5]); w.w = cvt_pk_bf16(r[6], r[7]);
                    bf16_t* dst = base + (size_t)(ai * HALF + m * 16) * DCONV;
                    asm volatile("global_store_dwordx4 %0, %1, off sc1\n\ts_nop 1" :: "v"(dst), "v"(w) : "memory");
                }
            asm volatile("s_waitcnt vmcnt(0)" ::: "memory");
            if ((threadIdx.x & 63) == 0) __hip_atomic_fetch_add((unsigned*)(ws + WS_CTL + CTL_UPAN) + 64 * pm, 1u, __ATOMIC_RELAXED, __HIP_MEMORY_SCOPE_AGENT);
        } else {
            const int which = (pn - 8) >> 2, hq = 4 * ((pn - 8) & 3) + (wc >> 1);
            const float sc = which == 0 ? QSCALE : 1.f;
            bf16_t* base = QKV + (size_t)which * ((size_t)NH * SEQ * HD) + (size_t)row0 * HD + (wc & 1) * 32 + 8 * fq;
#pragma unroll
            for (int ai = 0; ai < 2; ++ai)
#pragma unroll
                for (int m = 0; m < 4; ++m)
#pragma unroll
                    for (int bj = 0; bj < 2; ++bj) {
                        const f32x4 v0 = acc[ai][bj][m][0] * sc, v1 = acc[ai][bj][m][1] * sc;
                        v4u w; w.x = cvt_pk_bf16(v0[0], v0[1]); w.y = cvt_pk_bf16(v0[2], v0[3]); w.z = cvt_pk_bf16(v1[0], v1[1]); w.w = cvt_pk_bf16(v1[2], v1[3]);
                        *(v4u*)(base + ((size_t)(hq + 2 * bj) * SEQ + ai * HALF + m * 16) * HD) = w;
                    }
        }
    }
};
struct EpiOut {
    CParams P;
    __device__ __forceinline__ void operator()(const f32x4 (&acc)[2][2][4][2], const Unit& u, int wr, int wc, int fr, int fq) const {
        CParams Q = relaunder(P);
        const float* x = Q->x; const float* g2 = Q->norm2_g; unsigned char* ws = Q->ws;
        bf16_t* X1 = (bf16_t*)(ws + WS_X1); bf16_t* X1G = (bf16_t*)(ws + WS_X1G); float* SSP = (float*)(ws + WS_SSP);
        const int pm = u.i0, pn = u.i1;
        const int row0 = pm * BM + wr * 64 + fr, col0 = pn * BM + wc * 32 + 8 * fq;
        f32x4 gv[2][2];
#pragma unroll
        for (int bj = 0; bj < 2; ++bj)
#pragma unroll
            for (int n = 0; n < 2; ++n) gv[bj][n] = *(const f32x4*)(g2 + col0 + bj * HALF + 4 * n);
#pragma unroll
        for (int ai = 0; ai < 2; ++ai)
#pragma unroll
            for (int m = 0; m < 4; ++m) {
                const int row = row0 + ai * HALF + m * 16; const size_t off = (size_t)row * DM + col0;
                float q = 0.f;
#pragma unroll
                for (int bj = 0; bj < 2; ++bj) {
                    const f32x4 s0 = *(const f32x4*)(x + off + bj * HALF) + acc[ai][bj][m][0], s1 = *(const f32x4*)(x + off + bj * HALF + 4) + acc[ai][bj][m][1];
                    { v4u w1; w1.x = cvt_pk_bf16(s0[0], s0[1]); w1.y = cvt_pk_bf16(s0[2], s0[3]); w1.z = cvt_pk_bf16(s1[0], s1[1]); w1.w = cvt_pk_bf16(s1[2], s1[3]); *(v4u*)(X1 + off + bj * HALF) = w1; }
                    q += (s0[0] * s0[0] + s0[1] * s0[1]) + (s0[2] * s0[2] + s0[3] * s0[3]) + (s1[0] * s1[0] + s1[1] * s1[1]) + (s1[2] * s1[2] + s1[3] * s1[3]);
                    const f32x4 t0 = s0 * gv[bj][0], t1 = s1 * gv[bj][1];
                    v4u w; w.x = cvt_pk_bf16(t0[0], t0[1]); w.y = cvt_pk_bf16(t0[2], t0[3]); w.z = cvt_pk_bf16(t1[0], t1[1]); w.w = cvt_pk_bf16(t1[2], t1[3]);
                    *(v4u*)(X1G + (size_t)row * X1GLD + col0 + bj * HALF) = w;
                }
                q += __shfl_xor(q, 16); q += __shfl_xor(q, 32);
                if (fq == 0) SSP[(size_t)(pn * 4 + wc) * SEQ + row] = q;
            }
    }
};
constexpr int TAB_TS = 0, TAB_OS = 65, TAB_CN = 130, TAB_SNAKE = 195, TAB_TI = 200;
}


#define XB_TMO      128
#define XB_XCNT(j)  (256  + 64 * (j))
#define XB_XSUB(j)  (1280 + 64 * (j))
#define XB_XGEN(j)  (2304 + 64 * (j))
#define XB_TOP      3328
#define XB_TOPGEN   3392
#define XCD_BAR_WORDS 3456
#define XB_SPIN_CAP (1u << 18)
__device__ __forceinline__ unsigned xb_ld(unsigned* p)              { return __hip_atomic_load(p, __ATOMIC_RELAXED, __HIP_MEMORY_SCOPE_AGENT); }
__device__ __forceinline__ unsigned xb_add(unsigned* p, unsigned v) { return __hip_atomic_fetch_add(p, v, __ATOMIC_RELAXED, __HIP_MEMORY_SCOPE_AGENT); }
__device__ __forceinline__ unsigned xb_xcc_id() { return (unsigned)__builtin_amdgcn_s_getreg((3 << 11) | 20) & 0xFu; }
#define XB_SPIN(cond, bar) do { unsigned _sp = 0; while (cond) { __builtin_amdgcn_s_sleep(1); \
    if ((++_sp & 255u) == 0u) { if (xb_ld(&(bar)[XB_TMO])) break; if (_sp > XB_SPIN_CAP) { atomicAdd(&(bar)[XB_TMO], 1u); break; } } } } while (0)
struct XcdBarrier { unsigned* bar; unsigned x; volatile LAS unsigned* st; };
__device__ __forceinline__ XcdBarrier xcd_barrier_post(unsigned* bar, volatile LAS unsigned* st) {
    XcdBarrier b; b.bar = bar; b.x = xb_xcc_id(); b.st = st;
    if (threadIdx.x == 0) (void)xb_add(&bar[XB_XCNT(b.x)], 1u);
    return b;
}
__device__ __forceinline__ void xcd_barrier_complete(unsigned* bar, unsigned x, unsigned& nloc, unsigned& nx) {
    const unsigned G = gridDim.x * gridDim.y * gridDim.z;
    unsigned sum, cnt, mine, sp = 0u;
    for (;;) {
        sum = 0u; cnt = 0u; mine = 0u;
#pragma unroll
        for (unsigned j = 0; j < 16; ++j) { const unsigned c = xb_ld(&bar[XB_XCNT(j)]); sum += c; cnt += (c > 0u) ? 1u : 0u; mine = (j == x) ? c : mine; }
        if (sum == G) break;
        __builtin_amdgcn_s_sleep(1);
        if ((++sp & 255u) == 0u) { if (xb_ld(&bar[XB_TMO])) break; if (sp > XB_SPIN_CAP) { atomicAdd(&bar[XB_TMO], 1u); break; } }
    }
    nloc = mine > 0u ? mine : 1u; nx = cnt > 0u ? cnt : 1u;
}
__device__ __forceinline__ void xcd_barrier(const XcdBarrier& b) {
    asm volatile("s_waitcnt vmcnt(0)" ::: "memory");
    __syncthreads();
    if (threadIdx.x == 0) {
        unsigned* bar = b.bar;
        __builtin_amdgcn_s_waitcnt(0);
        unsigned nloc = b.st[0], nx = b.st[1];
        if (nloc == 0u) { xcd_barrier_complete(bar, b.x, nloc, nx); b.st[0] = nloc; b.st[1] = nx; }
        const unsigned old = xb_add(&bar[XB_XSUB(b.x)], 1u);
        const unsigned gen = old / nloc;
        if (old + 1u == (gen + 1u) * nloc) {
            __builtin_amdgcn_fence(__ATOMIC_RELEASE, "agent");
            asm volatile("s_waitcnt vmcnt(0)" ::: "memory");
            const unsigned og = xb_add(&bar[XB_TOP], 1u);
            const unsigned tg = og / nx;
            if (og + 1u == (tg + 1u) * nx) xb_add(&bar[XB_TOPGEN], 1u);
            else XB_SPIN(xb_ld(&bar[XB_TOPGEN]) == tg, bar);
            __builtin_amdgcn_fence(__ATOMIC_ACQUIRE, "agent");
            xb_add(&bar[XB_XGEN(b.x)], 1u);
            asm volatile("s_waitcnt vmcnt(0)" ::: "memory");
        } else {
            XB_SPIN(xb_ld(&bar[XB_XGEN(b.x)]) == gen, bar);
            __builtin_amdgcn_fence(__ATOMIC_ACQUIRE, "agent");
            asm volatile("s_waitcnt vmcnt(0)" ::: "memory");
        }
    }
    __syncthreads();
}


typedef short v4i16_t __attribute__((ext_vector_type(4)));
constexpr int ATT_BUF = 16384, ATT_V = 8192, ATT_BIAS = 32768;
__device__ __forceinline__ int crow(int r, int hi) { return (r & 3) + 8 * (r >> 2) + 4 * hi; }
__device__ __forceinline__ void attn_unit(CParams P, int h, int cg, LAS unsigned char* lds) {
    const int tid = threadIdx.x, lane = tid & 63, wave = __builtin_amdgcn_readfirstlane(tid >> 6), r32 = lane & 31, hi = lane >> 5;
    unsigned char* ws = P->ws;
    const bf16_t* Qh = (const bf16_t*)(ws + WS_QH) + (size_t)h * SEQ * HD; const bf16_t* Kh = (const bf16_t*)(ws + WS_KH) + (size_t)h * SEQ * HD;
    const bf16_t* Vh = (const bf16_t*)(ws + WS_VH) + (size_t)h * SEQ * HD; bf16_t* MIX = (bf16_t*)(ws + WS_MIX);
    const int c = cg * 8 + wave;
    LAS float* bias = (LAS float*)(lds + ATT_BIAS);
    __syncthreads();
    for (int i = tid; i < NREL; i += NTHR) bias[i] = P->rel_bias[h * NREL + i] * LOG2E;
    bf16x8 qf[2][4];
#pragma unroll
    for (int qb = 0; qb < 2; ++qb)
#pragma unroll
        for (int s = 0; s < 4; ++s) qf[qb][s] = *(const bf16x8*)(Qh + (size_t)(c * 64 + qb * 32 + r32) * HD + s * 16 + hi * 8);
#pragma unroll
    for (int qb = 0; qb < 2; ++qb)
#pragma unroll
        for (int s = 0; s < 4; ++s) asm volatile("" : "+v"(qf[qb][s]));
    float mrun[2] = {0.f, 0.f}, lrun[2] = {0.f, 0.f};
    f32x16 O[2][2];
#pragma unroll
    for (int a = 0; a < 2; ++a)
#pragma unroll
        for (int b = 0; b < 2; ++b)
#pragma unroll
            for (int r = 0; r < 16; ++r) O[a][b][r] = 0.f;
    const int kt0 = cg * 8 - 8 < 0 ? 0 : cg * 8 - 8, kt1 = cg * 8 + 7;
    const int skey = tid >> 3, sch = tid & 7;
    const bf16_t* Kg = Kh + (size_t)skey * HD + sch * 8; const bf16_t* Vg = Vh + (size_t)skey * HD + sch * 8;
    const int kwoff = skey * 128 + ((sch ^ (skey & 7)) << 4), vwoff = ATT_V + skey * 128 + (sch << 4);
    v4u kreg = *(const v4u*)(Kg + (size_t)kt0 * 64 * HD), vreg = *(const v4u*)(Vg + (size_t)kt0 * 64 * HD);
    *(LAS v4u*)(lds + kwoff) = kreg; *(LAS v4u*)(lds + vwoff) = vreg;
    __syncthreads();
    const int kroff = r32 * 128;
    const int vq = (lane & 15) >> 2, vp = lane & 3, vg1 = (lane >> 4) & 1;
    const int vroff = ATT_V + (4 * hi + vq) * 128 + (16 * vg1 + 4 * vp) * 2;
    for (int kt = kt0; kt <= kt1; ++kt) {
        const int cur = (kt - kt0) & 1;
        if (kt < kt1) { kreg = *(const v4u*)(Kg + (size_t)(kt + 1) * 64 * HD); vreg = *(const v4u*)(Vg + (size_t)(kt + 1) * 64 * HD); }
        if (kt >= c - 8 && kt <= c) {
            const int tt = kt - (c - 8);
            LAS unsigned char* buf = lds + cur * ATT_BUF;
            bf16x8 kf[2][4];
#pragma unroll
            for (int kh = 0; kh < 2; ++kh)
#pragma unroll
                for (int s = 0; s < 4; ++s) kf[kh][s] = *(const LAS bf16x8*)(buf + kh * 4096 + kroff + (((2 * s + hi) ^ (r32 & 7)) << 4));
            bf16x8 pb[2][2][2];
#pragma unroll
            for (int qb = 0; qb < 2; ++qb) {
                f32x16 S0, S1;
                const float nm = -mrun[qb];
                if (tt <= 5) { const float b = bias[2 * RCLIP] + nm;
#pragma unroll
                    for (int r = 0; r < 16; ++r) { S0[r] = b; S1[r] = b; } }
                else { const int base = LEFT * CHUNK - 64 * tt + qb * 32 + r32;
#pragma unroll
                    for (int r = 0; r < 16; ++r) { int d0 = base - crow(r, hi), d1 = d0 - 32;
                        d0 = d0 > RCLIP ? RCLIP : (d0 < -RCLIP ? -RCLIP : d0); d1 = d1 > RCLIP ? RCLIP : (d1 < -RCLIP ? -RCLIP : d1);
                        S0[r] = bias[d0 + RCLIP] + nm; S1[r] = bias[d1 + RCLIP] + nm; } }
#pragma unroll
                for (int s = 0; s < 4; ++s) { S0 = __builtin_amdgcn_mfma_f32_32x32x16_bf16(kf[0][s], qf[qb][s], S0, 0, 0, 0); S1 = __builtin_amdgcn_mfma_f32_32x32x16_bf16(kf[1][s], qf[qb][s], S1, 0, 0, 0); }
                float mx = fmaxf(S0[0], S1[0]);
#pragma unroll
                for (int r = 1; r < 16; ++r) mx = fmaxf(mx, fmaxf(S0[r], S1[r]));
                mx = fmaxf(mx, __shfl_xor(mx, 32));
                if (__any(mx > 6.f)) {
                    const float dl = fmaxf(mx, 0.f), alpha = __builtin_amdgcn_exp2f(-dl);
                    mrun[qb] += dl; lrun[qb] *= alpha;
#pragma unroll
                    for (int r = 0; r < 16; ++r) { S0[r] -= dl; S1[r] -= dl; O[qb][0][r] *= alpha; O[qb][1][r] *= alpha; }
                }
                float rs = 0.f;
#pragma unroll
                for (int r = 0; r < 16; ++r) { S0[r] = __builtin_amdgcn_exp2f(S0[r]); S1[r] = __builtin_amdgcn_exp2f(S1[r]); rs += S0[r] + S1[r]; }
                rs += __shfl_xor(rs, 32);
                lrun[qb] += rs;
#pragma unroll
                for (int s2 = 0; s2 < 2; ++s2) {
                    v4u w0, w1;
                    w0.x = g8::cvt_pk_bf16(S0[8 * s2 + 0], S0[8 * s2 + 1]); w0.y = g8::cvt_pk_bf16(S0[8 * s2 + 2], S0[8 * s2 + 3]); w0.z = g8::cvt_pk_bf16(S0[8 * s2 + 4], S0[8 * s2 + 5]); w0.w = g8::cvt_pk_bf16(S0[8 * s2 + 6], S0[8 * s2 + 7]);
                    w1.x = g8::cvt_pk_bf16(S1[8 * s2 + 0], S1[8 * s2 + 1]); w1.y = g8::cvt_pk_bf16(S1[8 * s2 + 2], S1[8 * s2 + 3]); w1.z = g8::cvt_pk_bf16(S1[8 * s2 + 4], S1[8 * s2 + 5]); w1.w = g8::cvt_pk_bf16(S1[8 * s2 + 6], S1[8 * s2 + 7]);
                    pb[qb][0][s2] = __builtin_bit_cast(bf16x8, w0); pb[qb][1][s2] = __builtin_bit_cast(bf16x8, w1);
                }
            }
#pragma unroll
            for (int dh = 0; dh < 2; ++dh)
#pragma unroll
                for (int kh = 0; kh < 2; ++kh)
#pragma unroll
                    for (int s2 = 0; s2 < 2; ++s2) {
                        const LAS unsigned char* vp0 = buf + vroff + (32 * kh + 16 * s2) * 128 + 64 * dh;
                        const v4i16_t lo = __builtin_amdgcn_ds_read_tr16_b64_v4i16((LAS v4i16_t*)vp0);
                        const v4i16_t hv = __builtin_amdgcn_ds_read_tr16_b64_v4i16((LAS v4i16_t*)(vp0 + 8 * 128));
                        const bf16x8 vf = (bf16x8){lo[0], lo[1], lo[2], lo[3], hv[0], hv[1], hv[2], hv[3]};
                        O[0][dh] = __builtin_amdgcn_mfma_f32_32x32x16_bf16(vf, pb[0][kh][s2], O[0][dh], 0, 0, 0);
                        O[1][dh] = __builtin_amdgcn_mfma_f32_32x32x16_bf16(vf, pb[1][kh][s2], O[1][dh], 0, 0, 0);
                    }
        }
        if (kt < kt1) { LAS unsigned char* nb = lds + (cur ^ 1) * ATT_BUF; *(LAS v4u*)(nb + kwoff) = kreg; *(LAS v4u*)(nb + vwoff) = vreg; }
        __syncthreads();
    }
#pragma unroll
    for (int qb = 0; qb < 2; ++qb) {
        const float inv = 1.f / lrun[qb];
        bf16_t* orow = MIX + (size_t)(c * 64 + qb * 32 + r32) * DM + DCONV + h * HD + 4 * hi;
#pragma unroll
        for (int dh = 0; dh < 2; ++dh)
#pragma unroll
            for (int g = 0; g < 4; ++g) {
                v2u w; w.x = g8::cvt_pk_bf16(O[qb][dh][4 * g] * inv, O[qb][dh][4 * g + 1] * inv); w.y = g8::cvt_pk_bf16(O[qb][dh][4 * g + 2] * inv, O[qb][dh][4 * g + 3] * inv);
                *(v2u*)(orow + dh * 32 + 8 * g) = w;
            }
    }
}

constexpr int RT_RED = 0, RT_LOG = 8 * 32 * NRT * 4, RT_RS = RT_LOG + 32 * NRT * 4;
__device__ __forceinline__ void router_item(CParams P, int item, LAS unsigned char* lds) {
    const int tid = threadIdx.x, lane = tid & 63, wave = __builtin_amdgcn_readfirstlane(tid >> 6), fr = lane & 15, fq = lane >> 4;
    unsigned char* ws = P->ws;
    const bf16_t* X1G = (const bf16_t*)(ws + WS_X1G); const float* SSP = (const float*)(ws + WS_SSP); const bf16_t* WrT = (const bf16_t*)(ws + WS_WRT);
    float* RSTD2 = (float*)(ws + WS_RSTD2); int* cnt = (int*)(ws + WS_CTL + CTL_CNT); int* ltk = (int*)(ws + WS_LTK); float* lgt = (float*)(ws + WS_LGT);
    const int row0 = item * 32;
    LAS float* red = (LAS float*)(lds + RT_RED); LAS float* lg = (LAS float*)(lds + RT_LOG); LAS float* rsl = (LAS float*)(lds + RT_RS);
    f32x4 acc[2][5];
#pragma unroll
    for (int rb = 0; rb < 2; ++rb)
#pragma unroll
        for (int cb = 0; cb < 5; ++cb) acc[rb][cb] = (f32x4){0.f, 0.f, 0.f, 0.f};
    const bf16_t* ap = X1G + (size_t)(row0 + fr) * X1GLD + wave * 256 + fq * 8;
    const bf16_t* bp = WrT + (size_t)fr * DM + wave * 256 + fq * 8;
#pragma unroll
    for (int kh = 0; kh < 2; ++kh) {
        bf16x8 a[4][2], b[4][5];
#pragma unroll
        for (int k4 = 0; k4 < 4; ++k4) {
#pragma unroll
            for (int rb = 0; rb < 2; ++rb) a[k4][rb] = *(const bf16x8*)(ap + (size_t)rb * 16 * X1GLD + (kh * 4 + k4) * 32);
#pragma unroll
            for (int cb = 0; cb < 5; ++cb) b[k4][cb] = *(const bf16x8*)(bp + (size_t)cb * 16 * DM + (kh * 4 + k4) * 32);
        }
#pragma unroll
        for (int k4 = 0; k4 < 4; ++k4)
#pragma unroll
            for (int rb = 0; rb < 2; ++rb)
#pragma unroll
                for (int cb = 0; cb < 5; ++cb) acc[rb][cb] = __builtin_amdgcn_mfma_f32_16x16x32_bf16(a[k4][rb], b[k4][cb], acc[rb][cb], 0, 0, 0);
    }
    __syncthreads();
#pragma unroll
    for (int rb = 0; rb < 2; ++rb)
#pragma unroll
        for (int cb = 0; cb < 5; ++cb)
#pragma unroll
            for (int i = 0; i < 4; ++i) red[(wave * 32 + rb * 16 + 4 * fq + i) * NRT + cb * 16 + fr] = acc[rb][cb][i];
    {
        LAS float* ssl = (LAS float*)(lds + RT_RS + 256);
        if (tid < 64) { float s2 = 0.f;
#pragma unroll
            for (int i = 0; i < 16; ++i) s2 += SSP[(size_t)((tid >> 5) * 16 + i) * SEQ + row0 + (tid & 31)];
            ssl[tid] = s2; }
    }
    __syncthreads();
    if (tid < 32) {
        const LAS float* ssl = (const LAS float*)(lds + RT_RS + 256);
        const float rstd = rsqrtf((ssl[tid] + ssl[32 + tid]) * (1.f / DM) + 1e-6f);
        RSTD2[row0 + tid] = rstd; rsl[tid] = rstd;
    }
    for (int idx = tid; idx < 32 * NRT; idx += NTHR) {
        float s = 0.f;
#pragma unroll
        for (int w = 0; w < NWAVES; ++w) s += red[w * 32 * NRT + idx];
        lg[idx] = s;
    }
    __syncthreads();
    if (tid < 32) {
        const int t = row0 + tid; const float rstd = rsl[tid]; const LAS float* L = lg + tid * NRT;
        const float* bg = P->b_group; const float* be = P->b_er;
        float gmax = -INFINITY; int grp = 0; float glv[NG];
#pragma unroll
        for (int g = 0; g < NG; ++g) { glv[g] = L[g] * rstd + bg[g]; if (glv[g] > gmax) { gmax = glv[g]; grp = g; } }
        float sum = 0.f;
#pragma unroll
        for (int g = 0; g < NG; ++g) sum += __expf(glv[g] - gmax);
        const float pgrp = 1.f / sum;
        float v0 = -INFINITY, v1 = -INFINITY; int i0 = 0, i1 = 0;
        for (int i = 0; i < EPG; ++i) {
            const float v = L[NG + grp * EPG + i] * rstd + be[grp * EPG + i];
            if (v > v0) { v1 = v0; i1 = i0; v0 = v; i0 = i; } else if (v > v1) { v1 = v; i1 = i; }
        }
        const float e1 = __expf(v1 - v0), inv = 1.f / (1.f + e1);
        const int ea = grp * EPG + i0, eb = grp * EPG + i1;
        float* lrs = (float*)(ws + WS_LRS);
        const int sa = atomicAdd(&cnt[ea * CNT_STRIDE], 1); ltk[ea * LCAP + sa] = t * 2 + 0; lgt[ea * LCAP + sa] = inv * pgrp; lrs[ea * LCAP + sa] = rstd;
        const int sb = atomicAdd(&cnt[eb * CNT_STRIDE], 1); ltk[eb * LCAP + sb] = t * 2 + 1; lgt[eb * LCAP + sb] = e1 * inv * pgrp; lrs[eb * LCAP + sb] = rstd;
    }
}

__device__ __forceinline__ void moe_build_table(CParams P, LAS unsigned char* lds) {
    LAS int* tab = (LAS int*)(lds + LDS_TAB);
    __syncthreads();
    if (threadIdx.x < 64) {
        const int e = threadIdx.x;
        int* cnt = (int*)(P->ws + WS_CTL + CTL_CNT);
        const int c = __hip_atomic_load(cnt + e * CNT_STRIDE, __ATOMIC_RELAXED, __HIP_MEMORY_SCOPE_AGENT);
        const int n = (c + MTR - 1) / MTR;
        int ts = n, os = c, ov = n > 1 ? n - 1 : 0;
#pragma unroll
        for (int o = 1; o < 64; o <<= 1) { const int a_ = __shfl_up(ts, o), b_ = __shfl_up(os, o), c_ = __shfl_up(ov, o); if (e >= o) { ts += a_; os += b_; ov += c_; } }
        tab[g8::TAB_TS + e] = ts - n; tab[g8::TAB_OS + e] = os - c; tab[g8::TAB_CN + e] = c;
        if (e == 63) { tab[g8::TAB_TS + NE] = ts; tab[g8::TAB_OS + NE] = os; }
        int rank = 0; bool all_pos = true;
        for (int o = 0; o < 64; ++o) { const int co = __shfl(c, o); rank += (co > c || (co == c && o < e)) ? 1 : 0; all_pos = all_pos && co > 0; }
        if (all_pos) {
            if (n > 0) tab[g8::TAB_TI + rank] = (e << 8);
            for (int m = 1; m < n; ++m) tab[g8::TAB_TI + NE + (ov - (n - 1)) + m - 1] = (e << 8) | m;
        } else {
            for (int m = 0; m < n; ++m) tab[g8::TAB_TI + (ts - n) + m] = (e << 8) | m;
        }
        if (e == 0) tab[g8::TAB_SNAKE] = all_pos ? 1 : 0;
    }
    __syncthreads();
}
template <int NT>
__device__ __forceinline__ int moe_tile_of(const LAS int* tab, int L, int G) {
    if (tab[g8::TAB_SNAKE] && G == 256 && L < NE * NT) { const int tpr = 256 / NT, i = L >> 8, q = (L & 255) / NT; return i * tpr + ((i & 1) ? tpr - 1 - q : q); }
    return L / NT;
}

namespace m9 {
constexpr int SLOT = 16384;
#define M9_BAR() do { asm volatile("s_waitcnt lgkmcnt(0)" ::: "memory"); __builtin_amdgcn_s_barrier(); asm volatile("" ::: "memory"); } while (0)
template <bool DOWN>
__device__ __forceinline__ void moe_phase(CParams P, int vcu, int G, LAS unsigned char* lds) {
    const int tid = threadIdx.x, wid = __builtin_amdgcn_readfirstlane(tid >> 6), lane = tid & 63, fr = lane & 15, fq = lane >> 4;
    const LAS int* tab = (const LAS int*)(lds + LDS_TAB);
    unsigned char* ws = P->ws;
    constexpr int NT = DOWN ? 16 : 8, K = DOWN ? DE : DM, NKT = K / 64, ldb = DOWN ? DM : DE;
    const int nunits = tab[g8::TAB_TS + NE] * NT;
    if (vcu >= nunits) return;
    const int nmine = (nunits - vcu + G - 1) / G;
    const int total6 = (nmine * NKT + 5) / 6 * 6;
    if (wid >= 6) {
        const int pw = wid - 6, nq = lane & 15, kg = lane >> 4;
        const int col0 = DOWN ? 64 * pw + 4 * nq : 32 * ((4 * nq) >> 4) + 16 * pw + ((4 * nq) & 15);
        const int wbase = (16 * kg) * 256, c2 = 2 * col0;
        const unsigned voff = (unsigned)((16 * kg) * ldb + 4 * nq) * 4u;
        int qu = 0, qt = 0; const char* Bq;
#define M9_QPTR() do { const int Lq_ = vcu + (qu < nmine ? qu : nmine - 1) * G; const int Tq_ = moe_tile_of<NT>(tab, Lq_, G), ntq_ = Lq_ % NT; const int eq_ = __builtin_amdgcn_readfirstlane(tab[g8::TAB_TI + Tq_]) >> 8; \
        if (DOWN) Bq = (const char*)(P->w_down + (size_t)eq_ * DE * DM + 128 * ntq_ + 64 * pw); \
        else Bq = (const char*)((pw ? P->w_up : P->w_gate) + (size_t)eq_ * DM * DE + 64 * ntq_); } while (0)
        M9_QPTR();
        f32x4 rb[3][16];
#define M9_BLOAD(set) do { const char* s_ = Bq + (size_t)(qu < nmine ? qt : 0) * (64 * ldb * 4); _Pragma("unroll") for (int j_ = 0; j_ < 16; ++j_) rb[set][j_] = *(const f32x4*)(s_ + (size_t)j_ * (ldb * 4) + voff); \
        if (++qt == NKT) { qt = 0; ++qu; M9_QPTR(); } } while (0)
#define M9_BWRITE(set, sl) do { LAS unsigned char* d_ = lds + (sl) * SLOT + wbase; _Pragma("unroll") for (int j_ = 0; j_ < 16; ++j_) { v2u x_; \
        x_.x = g8::cvt_pk_bf16(rb[set][j_][0], rb[set][j_][1]); x_.y = g8::cvt_pk_bf16(rb[set][j_][2], rb[set][j_][3]); *(LAS v2u*)(d_ + j_ * 256 + (c2 ^ (((j_ & 3) + 4 * ((j_ >> 3) & 1)) << 5))) = x_; } } while (0)
        M9_BLOAD(0); M9_BLOAD(1); M9_BLOAD(2);
        M9_BWRITE(0, 0);
        M9_BLOAD(0);
        M9_BAR();
#define M9_PSTEP(set, sl) do { M9_BWRITE(set, sl); M9_BLOAD(set); M9_BAR(); } while (0)
#pragma unroll 1
        for (int s = 0; s < total6; s += 6) {
            M9_PSTEP(1, 1); M9_PSTEP(2, 0); M9_PSTEP(0, 1); M9_PSTEP(1, 0); M9_PSTEP(2, 1); M9_PSTEP(0, 0);
        }
#undef M9_QPTR
#undef M9_BLOAD
#undef M9_BWRITE
#undef M9_PSTEP
    } else {
        const int* ltk = (const int*)(ws + WS_LTK);
        const char* Ab = (const char*)ws + (DOWN ? WS_HM : WS_X1G);
        const int tq = fr >> 2, tp = fr & 3;
        const int rrow = (8 * fq + tq) * 256 + 8 * tp, thx = (tq + 4 * (fq & 1)) << 5;
#define M9_DECODE(L_, e_, mt_, nt_, ce_, ob_) do { const int T_ = moe_tile_of<NT>(tab, (L_), G); nt_ = (L_) % NT; const int ti_ = __builtin_amdgcn_readfirstlane(tab[g8::TAB_TI + T_]); e_ = ti_ >> 8; mt_ = ti_ & 255; \
        ce_ = __builtin_amdgcn_readfirstlane(tab[g8::TAB_CN + e_]); ob_ = __builtin_amdgcn_readfirstlane(tab[g8::TAB_OS + e_]); } while (0)
#define M9_IDX(m_, mt_, ce_) ({ int i_ = (mt_) * MTR + 16 * (wid + 6 * (m_)) + fr; i_ < (ce_) ? i_ : (ce_) - 1; })
#define M9_OFF(raw_) ((DOWN ? (unsigned)(raw_) * (unsigned)(DE * 2) : (unsigned)((raw_) >> 1) * (unsigned)(X1GLD * 2)) + (unsigned)fq * 16u)
#define M9_RAW(m_, e_, mt_, ce_, ob_) (DOWN ? (ob_) + M9_IDX(m_, mt_, ce_) : ltk[(e_) * LCAP + M9_IDX(m_, mt_, ce_)])
        int L = vcu;
        int e, mt, nt, ce, ob; M9_DECODE(L, e, mt, nt, ce, ob);
        unsigned aro[3];
#pragma unroll
        for (int m = 0; m < 3; ++m) aro[m] = M9_OFF(M9_RAW(m, e, mt, ce, ob));
        unsigned aro3 = M9_OFF(M9_RAW(3, e, mt, ce, ob));
        f32x4 acc[4][8];
#pragma unroll
        for (int m = 0; m < 4; ++m)
#pragma unroll
            for (int n = 0; n < 8; ++n) acc[m][n] = (f32x4){0.f, 0.f, 0.f, 0.f};
        bf16x8 A0[3][2], A1[3][2], A3[2];
#define M9_ALOAD(dst, t) do { const unsigned to_ = (unsigned)(t) * 128u; _Pragma("unroll") for (int m_ = 0; m_ < 3; ++m_) _Pragma("unroll") for (int k_ = 0; k_ < 2; ++k_) \
            dst[m_][k_] = *(const bf16x8*)(Ab + aro[m_] + to_ + k_ * 64); } while (0)
#define M9_BFRAG(dst, sl, nb_, ks_) do { const LAS unsigned char* p_ = lds + (sl) * SLOT + (rrow + (((nb_) << 5) ^ thx)) + (ks_) * 8192; \
            const v4i16_t lo_ = __builtin_amdgcn_ds_read_tr16_b64_v4i16((LAS v4i16_t*)p_); const v4i16_t hi_ = __builtin_amdgcn_ds_read_tr16_b64_v4i16((LAS v4i16_t*)(p_ + 1024)); \
            dst = (bf16x8){lo_[0], lo_[1], lo_[2], lo_[3], hi_[0], hi_[1], hi_[2], hi_[3]}; } while (0)
#define M9_COMPUTE(Acur, sl) do { _Pragma("unroll") for (int nb_ = 0; nb_ < 8; ++nb_) { bf16x8 b0_, b1_; M9_BFRAG(b0_, sl, nb_, 0); M9_BFRAG(b1_, sl, nb_, 1); \
            _Pragma("unroll") for (int m_ = 0; m_ < 2; ++m_) { acc[m_][nb_] = __builtin_amdgcn_mfma_f32_16x16x32_bf16(b0_, Acur[m_][0], acc[m_][nb_], 0, 0, 0); \
                acc[m_][nb_] = __builtin_amdgcn_mfma_f32_16x16x32_bf16(b1_, Acur[m_][1], acc[m_][nb_], 0, 0, 0); } \
            if (three) { acc[2][nb_] = __builtin_amdgcn_mfma_f32_16x16x32_bf16(b0_, Acur[2][0], acc[2][nb_], 0, 0, 0); \
                acc[2][nb_] = __builtin_amdgcn_mfma_f32_16x16x32_bf16(b1_, Acur[2][1], acc[2][nb_], 0, 0, 0); } \
            if (four) { acc[3][nb_] = __builtin_amdgcn_mfma_f32_16x16x32_bf16(b0_, A3[0], acc[3][nb_], 0, 0, 0); \
                acc[3][nb_] = __builtin_amdgcn_mfma_f32_16x16x32_bf16(b1_, A3[1], acc[3][nb_], 0, 0, 0); } } } while (0)
#define M9_A3LOAD(t) do { if (four) { const char* s3_ = Ab + aro3 + (unsigned)(t) * 128u; A3[0] = *(const bf16x8*)s3_; A3[1] = *(const bf16x8*)(s3_ + 64); } } while (0)
        M9_ALOAD(A0, 0);
        M9_BAR();
        for (;;) {
            const bool three = 16 * (wid + 12) < min(ce - mt * MTR, MTR), four = 16 * (wid + 18) < min(ce - mt * MTR, MTR);
            const int Ln = L + G; const bool has_next = Ln < nunits;
            int e2, mt2, nt2, ce2, ob2; M9_DECODE(has_next ? Ln : L, e2, mt2, nt2, ce2, ob2);
            int rtn[4]; float eg[4]; int etk[4];
#pragma unroll
            for (int m = 0; m < 4; ++m) {
                const int i1 = M9_IDX(m, mt, ce);
                rtn[m] = M9_RAW(m, e2, mt2, ce2, ob2);
                if (DOWN) { etk[m] = ltk[e * LCAP + i1]; eg[m] = ((const float*)(ws + WS_LGT))[e * LCAP + i1]; }
                else { etk[m] = 0; eg[m] = ((const float*)(ws + WS_LRS))[e * LCAP + i1]; }
            }
#pragma unroll 1
            for (int t2 = 0; t2 < NKT; t2 += 2) {
                M9_A3LOAD(t2); M9_ALOAD(A1, t2 + 1); __builtin_amdgcn_sched_barrier(0);
                M9_COMPUTE(A0, 0);
                M9_BAR();
                M9_A3LOAD(t2 + 1);
                if (t2 == NKT - 2) {
#pragma unroll
                    for (int m = 0; m < 3; ++m) aro[m] = M9_OFF(rtn[m]);
                    M9_ALOAD(A0, 0);
                } else M9_ALOAD(A0, t2 + 2);
                __builtin_amdgcn_sched_barrier(0);
                M9_COMPUTE(A1, 1);
                M9_BAR();
            }
            aro3 = M9_OFF(rtn[3]);
#pragma unroll
            for (int m = 0; m < 4; ++m) {
                const int idx = mt * MTR + 16 * (wid + 6 * m) + fr;
                if (idx < ce) {
                    if (DOWN) {
                        bf16_t* rowp = (bf16_t*)(ws + WS_Y) + (size_t)etk[m] * DM + nt * 128 + 4 * fq;
#pragma unroll
                        for (int n = 0; n < 8; ++n) { const f32x4 v = acc[m][n] * eg[m]; v2u w; w.x = g8::cvt_pk_bf16(v[0], v[1]); w.y = g8::cvt_pk_bf16(v[2], v[3]); *(v2u*)(rowp + 16 * n) = w; }
                    } else {
                        bf16_t* rowp = (bf16_t*)(ws + WS_HM) + (size_t)(ob + idx) * DE + nt * 64 + 4 * fq; const float rs = eg[m];
#pragma unroll
                        for (int j = 0; j < 4; ++j) {
                            float h[4];
#pragma unroll
                            for (int i = 0; i < 4; ++i) { const float g = acc[m][2 * j][i] * rs, uu = acc[m][2 * j + 1][i] * rs; h[i] = g * __builtin_amdgcn_rcpf(1.f + __expf(-g)) * uu; }
                            v2u w; w.x = g8::cvt_pk_bf16(h[0], h[1]); w.y = g8::cvt_pk_bf16(h[2], h[3]);
                            *(v2u*)(rowp + 16 * j) = w;
                        }
                    }
                }
            }
            if (!has_next) break;
            L = Ln; e = e2; mt = mt2; nt = nt2; ce = ce2; ob = ob2;
#pragma unroll
            for (int m = 0; m < 4; ++m)
#pragma unroll
                for (int n = 0; n < 8; ++n) acc[m][n] = (f32x4){0.f, 0.f, 0.f, 0.f};
        }
        for (int s = nmine * NKT; s < total6; ++s) M9_BAR();
#undef M9_DECODE
#undef M9_IDX
#undef M9_OFF
#undef M9_RAW
#undef M9_ALOAD
#undef M9_A3LOAD
#undef M9_BFRAG
#undef M9_COMPUTE
    }
}
#undef M9_BAR
}
constexpr int LDS_BYTES = 147456;
__global__ void __launch_bounds__(NTHR, 2) mega(Params p_kernarg) {
    extern __shared__ __attribute__((aligned(16))) unsigned char lds_raw[];
    LAS unsigned char* lds = (LAS unsigned char*)lds_raw;
    const int G = gridDim.x, bx = blockIdx.x;
    const int vcu = (G % 8 == 0) ? (bx % 8) * (G / 8) + bx / 8 : bx;
    CParams P = kparams();
    const int lo = P->ph_lo, hi = P->ph_hi;
#define IN(k) (lo <= (k) && (k) < hi)
#define BOTH(k) (IN(k) && IN((k) + 1))
    volatile LAS unsigned* misc = (volatile LAS unsigned*)(lds + LDS_MISC);
    if (threadIdx.x < 32) misc[threadIdx.x] = 0u;
    __syncthreads();
    XcdBarrier bar; bar.bar = (unsigned*)(P->ws + WS_CTL) + P->li * XCD_BAR_WORDS; bar.x = 0; bar.st = misc + 8;
    if (hi - lo > 1) bar = xcd_barrier_post(bar.bar, misc + 8);
#define GRID_BAR(k) do { if (BOTH(k)) xcd_barrier(bar); } while (0)
#define REPS(k) for (int rep_ = 0; rep_ < ((REP_PHASE == (k)) ? 2 : 1); ++rep_)
    if (IN(0)) REPS(0) { phase_prologue(kparams(), vcu, G, lds); GRID_BAR(0); }
    if (IN(1)) REPS(1) {
        g8::InOrder S; S.init(P->ws + WS_HB, P->ws + WS_WINT, DM, G, vcu);
        g8::EpiIn E{P};
        g8::gemm_phase<g8::EpiIn, g8::InOrder, false>(lds, DM, (size_t)g8::HALF * DM * 2, (size_t)g8::HALF * DM * 2, S, E);
        conv_queue(kparams(), lds);
        GRID_BAR(1);
    }
    if (IN(2)) REPS(2) {
        for (int r_ = 0; r_ < (REP_PHASE == 20 ? 2 : 1); ++r_) for (int u = vcu; u < NH * (SEQ / 512); u += G) attn_unit(kparams(), u >> 4, u & 15, lds);
        GRID_BAR(2);
    }
    if (IN(3)) REPS(3) {
        g8::DenseOrder S; S.init(P->ws + WS_MIX, P->ws + WS_WOUTT, SEQ, DM, DM, G, bx);
        g8::EpiOut E{P};
        g8::gemm_phase<g8::EpiOut, g8::DenseOrder, false>(lds, DM, (size_t)g8::HALF * DM * 2, (size_t)g8::HALF * DM * 2, S, E);
        GRID_BAR(3);
    }
    if (IN(4)) {
        for (int it = vcu; it < SEQ / 32; it += G) router_item(kparams(), it, lds);
        GRID_BAR(4);
    }
    if (IN(5)) REPS(5) { moe_build_table(kparams(), lds); m9::moe_phase<false>(kparams(), vcu, G, lds); GRID_BAR(5); }
    if (IN(6)) REPS(6) { moe_build_table(kparams(), lds); m9::moe_phase<true>(kparams(), vcu, G, lds); GRID_BAR(6); }
    if (IN(7)) REPS(7) phase_final(kparams(), vcu, G);
#undef REPS
#undef IN
#undef BOTH
#undef GRID_BAR
}

extern "C" void kernel_launch(void* const* d_in, const int* in_sizes, int n_in, void* d_out, int out_size, void* d_ws, size_t ws_size, hipStream_t stream) {
    static int grid = 0;
    if (grid == 0) {
        if (ws_size < WS_END) { fprintf(stderr, "kernel_launch: workspace too small (%zu < %zu)\n", ws_size, (size_t)WS_END); grid = -1; return; }
        int dev = 0, cus = 0, per_cu = 0;
        (void)hipGetDevice(&dev); (void)hipDeviceGetAttribute(&cus, hipDeviceAttributeMultiprocessorCount, dev);
        (void)hipFuncSetAttribute((const void*)mega, hipFuncAttributeMaxDynamicSharedMemorySize, LDS_BYTES);
        (void)hipOccupancyMaxActiveBlocksPerMultiprocessor(&per_cu, (const void*)mega, NTHR, LDS_BYTES);
        if (per_cu < 1) { fprintf(stderr, "kernel_launch: occupancy query says %d blocks per CU\n", per_cu); grid = -1; return; }
        grid = cus;
    }
    if (grid < 0) return;
    Params p{};
    p.x = (const float*)d_in[0]; p.norm1_g = (const float*)d_in[1]; p.w_in = (const float*)d_in[2]; p.w_dw = (const float*)d_in[3]; p.b_dw = (const float*)d_in[4];
    p.ln_g = (const float*)d_in[5]; p.ln_b = (const float*)d_in[6]; p.rel_bias = (const float*)d_in[7]; p.w_out = (const float*)d_in[8]; p.norm2_g = (const float*)d_in[9];
    p.w_group = (const float*)d_in[10]; p.b_group = (const float*)d_in[11]; p.w_er = (const float*)d_in[12]; p.b_er = (const float*)d_in[13];
    p.w_gate = (const float*)d_in[14]; p.w_up = (const float*)d_in[15]; p.w_down = (const float*)d_in[16]; p.final_g = (const float*)d_in[17];
    p.out = (float*)d_out; p.ws = (unsigned char*)d_ws;
    unsigned char* ws = (unsigned char*)d_ws;
    (void)hipMemsetAsync(ws + WS_CTL, 0, CTL_BYTES, stream);
    p.ph_lo = 0; p.ph_hi = 8; p.li = 0; p.pad = 0;
    hipLaunchKernelGGL(mega, dim3(grid), dim3(NTHR), LDS_BYTES, stream, p);
}
```

```cpp
#include <hip/hip_runtime.h>
#include <stdint.h>
#include <cstdio>

#define LAS __attribute__((address_space(3)))
#define GAS __attribute__((address_space(1)))
typedef unsigned short bf16_t;
typedef unsigned v4u __attribute__((ext_vector_type(4)));
typedef unsigned v2u __attribute__((ext_vector_type(2)));
typedef float f32x4 __attribute__((ext_vector_type(4)));
typedef float f32x16 __attribute__((ext_vector_type(16)));
typedef short bf16x8 __attribute__((ext_vector_type(8)));

constexpr int DM = 2048, SEQ = 8192, DCONV = 1024, DATT = 1024, HD = 64, NH = 16, DIN = 5120;
constexpr int CHUNK = 64, LEFT = 8, RCLIP = 128, NREL = 257, CW = 31;
constexpr int NG = 8, EPG = 8, NE = 64, DE = 512;
constexpr int LCAP = 8192;
constexpr int MTR = 384;
constexpr int NWAVES = 8, NTHR = 512;
constexpr int LDS_TAB = 131072;
constexpr int LDS_MISC = 131072 + 4096;
constexpr float LOG2E = 1.4426950408889634f;
constexpr float QSCALE = 0.125f * LOG2E;
constexpr int NRT = 80;

constexpr size_t MiB = 1ull << 20;
constexpr size_t WS_CTL = 0, CTL_BYTES = 16384;
constexpr size_t CTL_CNT = 524288;
constexpr int CNT_STRIDE = 64;
constexpr size_t CTL_UPAN = 600000 / 256 * 256;
constexpr size_t CTL_RPAN = CTL_UPAN + 32 * 256;
constexpr size_t CTL_CONVQ = CTL_UPAN + 64 * 256;
constexpr size_t CTL_WOQ = CTL_CONVQ + 64;
constexpr size_t CTL_DOWNQ = CTL_CONVQ + 128;
constexpr size_t CTL_UPC = CTL_CONVQ + 256;
constexpr size_t CTL_LQ = CTL_UPC + 64 * 256;
constexpr size_t CTL_ZERO_LO = CTL_CNT, CTL_ZERO_HI = CTL_LQ + 8 * 256;
static_assert(CTL_ZERO_HI <= 1 * MiB && CTL_CNT + NE * 64 * 4 <= CTL_UPAN, "control words");
constexpr size_t WS_LTK = 1 * MiB, WS_LGT = 3 * MiB, WS_RSTD2 = 5 * MiB, WS_SSP = 6 * MiB, WS_WRT = 7 * MiB;
constexpr size_t WS_WINT = 8 * MiB, WS_WOUTT = 28 * MiB, WS_HB = 36 * MiB, WS_U = 68 * MiB;
constexpr size_t WS_QH = 84 * MiB, WS_KH = 100 * MiB, WS_VH = 116 * MiB, WS_MIX = 132 * MiB;
constexpr size_t WS_X1 = 164 * MiB, WS_HM = 260 * MiB, WS_Y = 280 * MiB;
constexpr size_t WS_LRS = 384 * MiB;
constexpr size_t WS_END = 386 * MiB;

struct Params {
    const float *x, *norm1_g, *w_in, *w_dw, *b_dw, *ln_g, *ln_b, *rel_bias, *w_out, *norm2_g, *w_group, *b_group, *w_er, *b_er, *w_gate, *w_up, *w_down, *final_g;
    float* out; unsigned char* ws;
    int ph_lo, ph_hi, li, pad;
};

typedef const __attribute__((address_space(4))) Params* CParams;
__device__ __forceinline__ CParams kparams() { CParams kp = (CParams)__builtin_amdgcn_kernarg_segment_ptr(); asm volatile("" : "+s"(kp)); return kp; }
__device__ __forceinline__ CParams relaunder(CParams kp) { asm volatile("" : "+s"(kp)); return kp; }

__device__ __forceinline__ float bf2f(unsigned b) { return __uint_as_float(b << 16); }
__device__ __forceinline__ unsigned f2bf(float f) { unsigned u = __float_as_uint(f); return (u + 0x7fffu + ((u >> 16) & 1u)) >> 16; }
__device__ __forceinline__ unsigned pk2(float lo, float hi) { return f2bf(lo) | (f2bf(hi) << 16); }
__device__ __forceinline__ float wave_sum(float v) {
#pragma unroll
    for (int o = 1; o < 64; o <<= 1) v += __shfl_xor(v, o);
    return v;
}
__device__ __forceinline__ float wave_max(float v) {
#pragma unroll
    for (int o = 1; o < 64; o <<= 1) v = fmaxf(v, __shfl_xor(v, o));
    return v;
}
__device__ __forceinline__ float sigmoidf_(float x) { return 1.f / (1.f + __expf(-x)); }
__host__ __device__ __forceinline__ int wint_row(int n) {
    if (n < 1024) return 256 * (n >> 7) + (n & 127);
    if (n < 2048) { const int m = n - 1024; return 256 * (m >> 7) + 128 + (m & 127); }
    return n;
}

__device__ __forceinline__ void p0_transpose_item(const float* W, int ldw, int k0, int n0, bf16_t* WT, int K, int orow0, LAS float* scr, int lane) {
    float wv[32];
#pragma unroll
    for (int i = 0; i < 32; ++i) wv[i] = W[(size_t)(k0 + 2 * i + (lane >> 5)) * ldw + n0 + (lane & 31)];
#pragma unroll
    for (int i = 0; i < 32; ++i) scr[(2 * i + (lane >> 5)) * 33 + (lane & 31)] = wv[i];
    asm volatile("s_waitcnt lgkmcnt(0)" ::: "memory");
    const int c = lane & 7;
#pragma unroll
    for (int j = 0; j < 4; ++j) { const int n = (lane >> 3) + 8 * j; const LAS float* s = scr + (8 * c) * 33 + n;
        v4u o; o.x = pk2(s[0 * 33], s[1 * 33]); o.y = pk2(s[2 * 33], s[3 * 33]); o.z = pk2(s[4 * 33], s[5 * 33]); o.w = pk2(s[6 * 33], s[7 * 33]);
        *(v4u*)(WT + (size_t)(orow0 + n) * K + k0 + 8 * c) = o; }
    asm volatile("s_waitcnt lgkmcnt(0)" ::: "memory");
}

__device__ __forceinline__ void phase_prologue(CParams P, int vcu, int G, LAS unsigned char* lds) {
    const int tid = threadIdx.x, lane = tid & 63, wave = __builtin_amdgcn_readfirstlane(tid >> 6);
    LAS float* scr = (LAS float*)(lds + wave * 16384);
    const int gw = vcu * NWAVES + wave, NGW = G * NWAVES;
    bf16_t* WinT = (bf16_t*)(P->ws + WS_WINT); bf16_t* WrT = (bf16_t*)(P->ws + WS_WRT);
    bf16_t* Hb = (bf16_t*)(P->ws + WS_HB);
    float wr[2];
#pragma unroll
    for (int q = 0; q < 2; ++q) {
        const int idx = vcu * NTHR + tid + q * G * NTHR; wr[q] = 0.f;
        if (idx < NRT * DM) { const int n = idx / DM, k = idx % DM;
            float v = 0.f; if (n < NG) v = P->w_group[k * NG + n]; else if (n < NG + NE) v = P->w_er[k * NE + (n - NG)];
            wr[q] = v * P->norm2_g[k]; }
    }
    for (int m = gw; m < SEQ; m += 2 * NGW) {
        const int m2 = m + NGW < SEQ ? m + NGW : m;
        const f32x4* xr = (const f32x4*)(P->x + (size_t)m * DM) + lane; const f32x4* xr2 = (const f32x4*)(P->x + (size_t)m2 * DM) + lane;
        const f32x4* gr = (const f32x4*)P->norm1_g + lane;
        f32x4 v[8], v2[8]; float s = 0.f, s2 = 0.f;
#pragma unroll
        for (int j = 0; j < 8; ++j) { v[j] = xr[64 * j]; v2[j] = xr2[64 * j]; }
#pragma unroll
        for (int j = 0; j < 8; ++j) { s += (v[j].x * v[j].x + v[j].y * v[j].y) + (v[j].z * v[j].z + v[j].w * v[j].w); s2 += (v2[j].x * v2[j].x + v2[j].y * v2[j].y) + (v2[j].z * v2[j].z + v2[j].w * v2[j].w); }
        const float rstd = rsqrtf(wave_sum(s) * (1.f / DM) + 1e-6f), rstd2 = rsqrtf(wave_sum(s2) * (1.f / DM) + 1e-6f);
        v2u* o8 = (v2u*)(Hb + (size_t)m * DM) + lane; v2u* o82 = (v2u*)(Hb + (size_t)m2 * DM) + lane;
#pragma unroll
        for (int j = 0; j < 8; ++j) { const f32x4 g = gr[64 * j];
            v2u o; o.x = pk2(v[j].x * rstd * g.x, v[j].y * rstd * g.y); o.y = pk2(v[j].z * rstd * g.z, v[j].w * rstd * g.w); o8[64 * j] = o;
            v2u o2; o2.x = pk2(v2[j].x * rstd2 * g.x, v2[j].y * rstd2 * g.y); o2.y = pk2(v2[j].z * rstd2 * g.z, v2[j].w * rstd2 * g.w); o82[64 * j] = o2; }
    }
    constexpr int I_IN = (DM / 64) * (DIN / 32);
    const int i_full = (I_IN / NGW) * NGW;
    for (int it = gw; it < i_full; it += NGW) { const int nb = it % (DIN / 32), kb = it / (DIN / 32); p0_transpose_item(P->w_in, DIN, 64 * kb, 32 * nb, WinT, DM, wint_row(32 * nb), scr, lane); }
    { const int it = i_full + wave * G + vcu;
      if (it < I_IN) { const int nb = it % (DIN / 32), kb = it / (DIN / 32); p0_transpose_item(P->w_in, DIN, 64 * kb, 32 * nb, WinT, DM, wint_row(32 * nb), scr, lane); } }
    if (vcu == 0) { unsigned* z = (unsigned*)(P->ws + WS_CTL + CTL_ZERO_LO); for (int i = tid; i < (int)((CTL_ZERO_HI - CTL_ZERO_LO) / 4); i += NTHR) z[i] = 0u; }
#pragma unroll
    for (int q = 0; q < 2; ++q) { const int idx = vcu * NTHR + tid + q * G * NTHR; if (idx < NRT * DM) WrT[idx] = (bf16_t)f2bf(wr[q]); }
    for (int idx = (vcu * NTHR + tid) + 2 * G * NTHR; idx < NRT * DM; idx += G * NTHR) {
        const int n = idx / DM, k = idx % DM;
        float v = 0.f; if (n < NG) v = P->w_group[k * NG + n]; else if (n < NG + NE) v = P->w_er[k * NE + (n - NG)];
        WrT[idx] = (bf16_t)f2bf(v * P->norm2_g[k]);
    }
}

__device__ __forceinline__ void wout_queue(CParams P, LAS unsigned char* lds) {
    constexpr int I_OUT = (DM / 64) * (DM / 32);
    const int lane = threadIdx.x & 63, wave = __builtin_amdgcn_readfirstlane((int)threadIdx.x >> 6);
    bf16_t* WoutT = (bf16_t*)(P->ws + WS_WOUTT);
    volatile LAS int* slot = (volatile LAS int*)(lds + LDS_MISC + 64);
    LAS float* scr = (LAS float*)(lds + wave * 16384);
    for (;;) {
        __syncthreads();
        if (threadIdx.x == 0) slot[0] = 8 * (int)__hip_atomic_fetch_add((unsigned*)(P->ws + WS_CTL + CTL_WOQ), 1u, __ATOMIC_RELAXED, __HIP_MEMORY_SCOPE_AGENT);
        __syncthreads();
        const int it = slot[0] + wave;
        if (slot[0] >= I_OUT) break;
        if (it < I_OUT) { const int nb = it % (DM / 32), kb = it / (DM / 32); p0_transpose_item(P->w_out, DM, 64 * kb, 32 * nb, WoutT, DM, 32 * nb, scr, lane); }
    }
}

__device__ __forceinline__ void conv_queue(CParams P, LAS unsigned char* lds);
constexpr int CONV_T = 16, CONV_ROWS = CONV_T + CW - 1;
constexpr int CONV_LDS_RED = 96 * 1024;
struct ConvW { float w0[CW], w1[CW]; float2 bb, lg, lb; };
__device__ __forceinline__ void conv_item(CParams P, int item, LAS unsigned char* lds, const ConvW& cw) {
    const int tid = threadIdx.x, lane = tid & 63, wave = tid >> 6;
    const bf16_t* U = (const bf16_t*)(P->ws + WS_U); bf16_t* MIX = (bf16_t*)(P->ws + WS_MIX);
    const int t0 = item * CONV_T;
    __syncthreads();
    for (int idx = tid; idx < CONV_ROWS * 128; idx += NTHR) {
        const int r = idx >> 7, ch = idx & 127, t = t0 - (CW - 1) + r;
        v4u v = {0u, 0u, 0u, 0u}; if (t >= 0) v = *(const v4u*)(U + (size_t)t * DCONV + ch * 8);
        *(LAS v4u*)(lds + r * 2048 + ch * 16) = v;
    }
    const float (&w0)[CW] = cw.w0; const float (&w1)[CW] = cw.w1; const float2 bb = cw.bb;
    float a0[CONV_T], a1[CONV_T];
#pragma unroll
    for (int t = 0; t < CONV_T; ++t) { a0[t] = bb.x; a1[t] = bb.y; }
    __syncthreads();
#pragma unroll
    for (int r = 0; r < CONV_ROWS; ++r) {
        const unsigned u2 = *(const LAS unsigned*)(lds + r * 2048 + tid * 4);
        const float ua = bf2f(u2 & 0xffffu), ub = bf2f(u2 >> 16);
#pragma unroll
        for (int t = 0; t < CONV_T; ++t) { const int j = r - t; if (j >= 0 && j < CW) { a0[t] += w0[j] * ua; a1[t] += w1[j] * ub; } }
    }
    LAS float* red = (LAS float*)(lds + CONV_LDS_RED);
    LAS float* st = red + NWAVES * CONV_T * 2;
#pragma unroll
    for (int t = 0; t < CONV_T; ++t) {
        const float s = wave_sum(a0[t] + a1[t]), q = wave_sum(a0[t] * a0[t] + a1[t] * a1[t]);
        if (lane == 0) { red[(wave * CONV_T + t) * 2] = s; red[(wave * CONV_T + t) * 2 + 1] = q; }
    }
    __syncthreads();
    if (tid < CONV_T) {
        float s = 0.f, q = 0.f;
        for (int w = 0; w < NWAVES; ++w) { s += red[(w * CONV_T + tid) * 2]; q += red[(w * CONV_T + tid) * 2 + 1]; }
        const float mu = s * (1.f / DCONV), var = fmaxf(q * (1.f / DCONV) - mu * mu, 0.f);
        st[tid * 2] = mu; st[tid * 2 + 1] = rsqrtf(var + 1e-5f);
    }
    __syncthreads();
    const float2 lg = cw.lg, lb = cw.lb;
#pragma unroll
    for (int t = 0; t < CONV_T; ++t) {
        const float mu = st[t * 2], rs = st[t * 2 + 1];
        const float u0 = (a0[t] - mu) * rs * lg.x + lb.x, u1 = (a1[t] - mu) * rs * lg.y + lb.y;
        *(unsigned*)(MIX + (size_t)(t0 + t) * DM + 2 * tid) = pk2(u0 * sigmoidf_(u0), u1 * sigmoidf_(u1));
    }
}

__device__ __forceinline__ void conv_queue(CParams P, LAS unsigned char* lds) {
    unsigned char* ws = P->ws;
    unsigned* upan = (unsigned*)(ws + WS_CTL + CTL_UPAN); unsigned* head = (unsigned*)(ws + WS_CTL + CTL_CONVQ);
    volatile LAS int* slot = (volatile LAS int*)(lds + LDS_MISC + 64);
    ConvW cw; bool have_w = false;
    for (;;) {
        __syncthreads();
        if (threadIdx.x < 64) {
            int item = 0;
            if (threadIdx.x == 0) item = (int)__hip_atomic_fetch_add(head, 1u, __ATOMIC_RELAXED, __HIP_MEMORY_SCOPE_AGENT);
            item = __builtin_amdgcn_readfirstlane(item);
            if (item < SEQ / CONV_T) {
                const int t0 = item * CONV_T, pa = (t0 >= CW - 1 ? t0 - (CW - 1) : 0) >> 8, pb = (t0 + CONV_T - 1) >> 8;
                unsigned spins = 0;
                while ((unsigned)__builtin_amdgcn_readfirstlane(__hip_atomic_load(upan + 64 * pa, __ATOMIC_RELAXED, __HIP_MEMORY_SCOPE_AGENT)) < 64u ||
                       (unsigned)__builtin_amdgcn_readfirstlane(__hip_atomic_load(upan + 64 * pb, __ATOMIC_RELAXED, __HIP_MEMORY_SCOPE_AGENT)) < 64u) {
                    __builtin_amdgcn_s_sleep(8); if (++spins > (1u << 22)) break;
                }
                __builtin_amdgcn_fence(__ATOMIC_ACQUIRE, "agent");
                asm volatile("s_waitcnt vmcnt(0)" ::: "memory");
            }
            if (threadIdx.x == 0) slot[0] = item;
        }
        __syncthreads();
        const int item = slot[0];
        if (item >= SEQ / CONV_T) break;
        if (!have_w) {
            const int tid = threadIdx.x;
#pragma unroll
            for (int j = 0; j < CW; ++j) { const float2 w = *(const float2*)(P->w_dw + j * DCONV + 2 * tid); cw.w0[j] = w.x; cw.w1[j] = w.y; }
            cw.bb = *(const float2*)(P->b_dw + 2 * tid); cw.lg = *(const float2*)(P->ln_g + 2 * tid); cw.lb = *(const float2*)(P->ln_b + 2 * tid);
            have_w = true;
        }
        conv_item(P, item, lds, cw);
    }
}

__device__ __forceinline__ void phase_final(CParams P, int vcu, int G) {
    const int tid = threadIdx.x, lane = tid & 63, wave = tid >> 6;
    const bf16_t* X1 = (const bf16_t*)(P->ws + WS_X1); const bf16_t* Y = (const bf16_t*)(P->ws + WS_Y);
    for (int m = vcu * NWAVES + wave; m < SEQ; m += G * NWAVES) {
        const v2u* xr = (const v2u*)(X1 + (size_t)m * DM) + lane;
        const v2u* y0 = (const v2u*)(Y + (size_t)(2 * m) * DM) + lane; const v2u* y1 = (const v2u*)(Y + (size_t)(2 * m + 1) * DM) + lane;
        f32x4 v[8]; float s = 0.f;
#pragma unroll
        for (int j = 0; j < 8; ++j) {
            { const v2u xv = xr[64 * j]; v[j] = (f32x4){bf2f(xv.x & 0xffffu), bf2f(xv.x >> 16), bf2f(xv.y & 0xffffu), bf2f(xv.y >> 16)}; } const v2u a = y0[64 * j], b = y1[64 * j];
            v[j].x += bf2f(a.x & 0xffffu) + bf2f(b.x & 0xffffu); v[j].y += bf2f(a.x >> 16) + bf2f(b.x >> 16);
            v[j].z += bf2f(a.y & 0xffffu) + bf2f(b.y & 0xffffu); v[j].w += bf2f(a.y >> 16) + bf2f(b.y >> 16);
            s += (v[j].x * v[j].x + v[j].y * v[j].y) + (v[j].z * v[j].z + v[j].w * v[j].w);
        }
        const float rstd = rsqrtf(wave_sum(s) * (1.f / DM) + 1e-6f);
        f32x4* o = (f32x4*)(P->out + (size_t)m * DM) + lane; const f32x4* g = (const f32x4*)P->final_g + lane;
#pragma unroll
        for (int j = 0; j < 8; ++j) o[64 * j] = v[j] * rstd * g[64 * j];
    }
}

namespace g8 {
constexpr int BM = 256, BK = 64, HALF = 128, HTB = HALF * BK * 2, STAGE_BYTES = 8 * HTB, NXCD = 8, WGM = 8;
__host__ __device__ __forceinline__ int lds_byte(int r, int c) { const int st = (r >> 4) * 2 + (c >> 5), rr = r & 15, cc = c & 31, ob = rr * 64 + cc * 2; return st * 1024 + (ob ^ (((ob >> 9) & 1) << 5)); }
__host__ __device__ __forceinline__ void stage_rc(int b, int& R, int& C) { const int st = b / 1024, sb = b % 1024, swz = sb ^ (((sb >> 9) & 1) << 5); R = (st >> 1) * 16 + swz / 64; C = (st & 1) * 32 + (swz % 64) / 2; }
__host__ __device__ __forceinline__ int perm32(int rho) { const int n = rho >> 4, i = rho & 15; return 8 * (i >> 2) + 4 * n + (i & 3); }
__device__ __forceinline__ unsigned cvt_pk_bf16(float lo, float hi) { unsigned r; asm volatile("v_cvt_pk_bf16_f32 %0, %1, %2" : "=v"(r) : "v"(lo), "v"(hi)); return r; }

struct Unit { const char* a; const char* b; int i0, i1, i2; };

template <class Epi, class Sched, bool GATHER>
__device__ __forceinline__ void gemm_phase(LAS unsigned char* lds, const int K, const size_t astep, const size_t bstep, const Sched& S, const Epi& E) {
    const int tid = threadIdx.x, wid = __builtin_amdgcn_readfirstlane(tid >> 6), lane = tid & 63, wr = wid >> 2, wc = wid & 3, fr = lane & 15, fq = lane >> 4;
    const int nt = K / BK;
    unsigned voffB[2], voffA0[2], voffA1[2];
#pragma unroll
    for (int i = 0; i < 2; ++i) { int R, C; stage_rc(tid * 16 + i * 8192, R, C); const int Rb = (R & ~31) + perm32(R & 31);
        voffB[i] = (unsigned)(Rb * K + C) * 2u; voffA0[i] = (unsigned)(R * K + C) * 2u; voffA1[i] = voffA0[i]; }
    const size_t kstep = (size_t)(BK * 2);
    const unsigned ldsw = (unsigned)wid * 1024u;
    const int aoff = lds_byte(wr * 64 + fr, fq * 8), boff = lds_byte(wc * 32 + fr, fq * 8);
#define G8_SA(b, h) (((b) * 2 + (h)) * HTB)
#define G8_SB(b, h) ((4 + (b) * 2 + (h)) * HTB)
#define G8_STAGE(bufoff, gbase, voff) do { _Pragma("unroll") for (int _i = 0; _i < 2; ++_i) \
        __builtin_amdgcn_global_load_lds((const unsigned*)((const char*)(gbase) + (voff)[_i]), (LAS unsigned*)(lds + (bufoff) + ldsw + _i * 8192), 16, 0, 0); } while (0)
#define G8_LDA(dst, b, h) do { _Pragma("unroll") for (int m = 0; m < 4; ++m) _Pragma("unroll") for (int k = 0; k < 2; ++k) dst[m][k] = *(const LAS bf16x8*)(lds + G8_SA(b, h) + aoff + m * 2048 + k * 1024); } while (0)
#define G8_LDB(dst, b, h) do { _Pragma("unroll") for (int n = 0; n < 2; ++n) _Pragma("unroll") for (int k = 0; k < 2; ++k) dst[n][k] = *(const LAS bf16x8*)(lds + G8_SB(b, h) + boff + n * 2048 + k * 1024); } while (0)
#define G8_MMA(ai, bj, At, Bt) do { __builtin_amdgcn_s_setprio(1); _Pragma("unroll") for (int m = 0; m < 4; ++m) _Pragma("unroll") for (int n = 0; n < 2; ++n) _Pragma("unroll") for (int k = 0; k < 2; ++k) \
        acc[ai][bj][m][n] = __builtin_amdgcn_mfma_f32_16x16x32_bf16(Bt[n][k], At[m][k], acc[ai][bj][m][n], 0, 0, 0); __builtin_amdgcn_s_setprio(0); } while (0)
#define G8_WAIT_V(n) asm volatile("s_waitcnt vmcnt(" #n ")" ::: "memory")
#define G8_WAIT_L(n) asm volatile("s_waitcnt lgkmcnt(" #n ")" ::: "memory")
#define G8_BAR __builtin_amdgcn_s_barrier()
#define G8_SCHED __builtin_amdgcn_sched_barrier(0)
#define G8_GOFF(u) do { if (GATHER) { _Pragma("unroll") for (int _i = 0; _i < 2; ++_i) { int R_, C_; stage_rc(tid * 16 + _i * 8192, R_, C_); \
        voffA0[_i] = S.row_off(u, R_) + (unsigned)C_ * 2u; voffA1[_i] = S.row_off(u, R_ + HALF) + (unsigned)C_ * 2u; } } } while (0)
    Unit cur, nxt; int ui = 0;
    if (!S.next(0, cur)) return;
    f32x4 acc[2][2][4][2];
#pragma unroll
    for (int a = 0; a < 2; ++a)
#pragma unroll
        for (int b = 0; b < 2; ++b)
#pragma unroll
            for (int m = 0; m < 4; ++m)
#pragma unroll
                for (int n = 0; n < 2; ++n) acc[a][b][m][n] = (f32x4){0.f, 0.f, 0.f, 0.f};
    bf16x8 At[4][2], B0[2][2], B1[2][2];
    const char* cA0 = cur.a; const char* cB0 = cur.b;
#define cA1 (cA0 + astep)
#define cB1 (cB0 + bstep)
    G8_GOFF(cur);
    G8_STAGE(G8_SB(0, 0), cB0, voffB); G8_STAGE(G8_SB(0, 1), cB1, voffB); G8_STAGE(G8_SA(0, 0), cA0, voffA0); G8_STAGE(G8_SA(0, 1), cA1, voffA1);
    if (wr == 1) G8_BAR;
    G8_WAIT_V(2); G8_BAR;
    G8_STAGE(G8_SB(1, 0), cB0 + kstep, voffB); G8_STAGE(G8_SA(1, 0), cA0 + kstep, voffA0); G8_STAGE(G8_SB(1, 1), cB1 + kstep, voffB);
    G8_WAIT_V(6); G8_BAR;
    for (;;) {
        const bool has_next = S.next(ui + 1, nxt);
        const char* nA0 = has_next ? nxt.a : cA0; const char* nB0 = has_next ? nxt.b : cB0;
        for (int t = 0; t < nt; t += 2) {
            const bool last = (t == nt - 2);
            const char* a1h = cA1 + (size_t)(t + 1) * kstep;
            const char* a2_0 = last ? nA0 : cA0 + (size_t)(t + 2) * kstep; const char* a2_1 = a2_0 + astep;
            const char* b2_0 = last ? nB0 : cB0 + (size_t)(t + 2) * kstep; const char* b2_1 = b2_0 + bstep;
            const char* a3_0 = a2_0 + kstep; const char* b3_0 = b2_0 + kstep; const char* b3_1 = b2_1 + kstep;
            G8_LDB(B0, 0, 0); G8_LDB(B1, 0, 1); G8_SCHED; G8_LDA(At, 0, 0); G8_STAGE(G8_SA(1, 1), a1h, voffA1);
            G8_WAIT_V(8); G8_WAIT_L(0); G8_BAR; G8_MMA(0, 0, At, B0); G8_MMA(0, 1, At, B1); G8_BAR; G8_SCHED;
            if (GATHER) { if (last && has_next) { G8_GOFF(nxt); } }
            G8_LDA(At, 0, 1); G8_STAGE(G8_SB(0, 0), b2_0, voffB); G8_STAGE(G8_SB(0, 1), b2_1, voffB); G8_STAGE(G8_SA(0, 0), a2_0, voffA0);
            G8_WAIT_V(8); G8_WAIT_L(0); G8_BAR; G8_MMA(1, 0, At, B0); G8_MMA(1, 1, At, B1); G8_BAR; G8_SCHED;
            G8_LDB(B0, 1, 0); G8_LDB(B1, 1, 1); G8_SCHED; G8_LDA(At, 1, 0); G8_STAGE(G8_SA(0, 1), a2_1, voffA1);
            G8_WAIT_V(8); G8_WAIT_L(0); G8_BAR; G8_MMA(0, 0, At, B0); G8_MMA(0, 1, At, B1); G8_BAR; G8_SCHED;
            G8_LDA(At, 1, 1); G8_STAGE(G8_SB(1, 0), b3_0, voffB); G8_STAGE(G8_SB(1, 1), b3_1, voffB); G8_STAGE(G8_SA(1, 0), a3_0, voffA0);
            G8_WAIT_V(8); G8_WAIT_L(0); G8_BAR; G8_MMA(1, 0, At, B0); G8_MMA(1, 1, At, B1); G8_BAR; G8_SCHED;
        }
        if (wr == 0) G8_BAR;
        E(acc, cur, wr, wc, fr, fq);
        if (!has_next) break;
#pragma unroll
        for (int a = 0; a < 2; ++a)
#pragma unroll
            for (int b = 0; b < 2; ++b)
#pragma unroll
                for (int m = 0; m < 4; ++m)
#pragma unroll
                    for (int n = 0; n < 2; ++n) acc[a][b][m][n] = (f32x4){0.f, 0.f, 0.f, 0.f};
        cur = nxt; cA0 = nA0; cB0 = nB0; ++ui;
        if (wr == 1) G8_BAR;
    }
    G8_WAIT_V(0);
    G8_BAR;
#undef G8_SA
#undef G8_SB
#undef G8_STAGE
#undef G8_LDA
#undef G8_LDB
#undef G8_MMA
#undef G8_WAIT_V
#undef G8_WAIT_L
#undef G8_BAR
#undef G8_SCHED
#undef G8_GOFF
#undef cA1
#undef cB1
}

struct DenseOrder {
    int nM, nN, nwg, G, c, K; const char* A; const char* Bt;
    __device__ __forceinline__ void init(const void* A_, const void* Bt_, int M, int N, int K_, int G_, int c_) { A = (const char*)A_; Bt = (const char*)Bt_; nM = M / BM; nN = N / BM; nwg = nM * nN; G = G_; c = c_; K = K_; }
    __device__ __forceinline__ bool next(int i, Unit& u) const {
        const long L = (long)i * G + c; if (L >= nwg) return false;
        int wgid = (int)L; { const int q = nwg / NXCD, r = nwg % NXCD, xcd = wgid % NXCD, off = wgid / NXCD; wgid = (xcd < r ? xcd * (q + 1) : r * (q + 1) + (xcd - r) * q) + off; }
        const int nig = WGM * nN, gid = wgid / nig, fm = gid * WGM, gsz = (nM - fm) < WGM ? (nM - fm) : WGM;
        const int pm = fm + ((wgid % nig) % gsz), pn = (wgid % nig) / gsz;
        const size_t hstep = (size_t)HALF * K * 2;
        u.a = A + (size_t)pm * 2 * hstep; u.b = Bt + (size_t)pn * 2 * hstep; u.i0 = pm; u.i1 = pn; u.i2 = 0; return true;
    }
    __device__ __forceinline__ unsigned row_off(const Unit&, int) const { return 0u; }
};

struct InOrder {
    int G, c, K; const char* A; const char* Bt;
    __device__ __forceinline__ void init(const void* A_, const void* Bt_, int K_, int G_, int c_) { A = (const char*)A_; Bt = (const char*)Bt_; G = G_; c = c_; K = K_; }
    __device__ __forceinline__ bool next(int i, Unit& u) const {
        const int L = i * G + c; if (L >= 640) return false;
        int pm, pn; if (L < 256) { pm = L >> 3; pn = L & 7; } else { const int l2 = L - 256; pm = l2 / 12; pn = 8 + l2 % 12; }
        const size_t hstep = (size_t)HALF * K * 2;
        u.a = A + (size_t)pm * 2 * hstep; u.b = Bt + (size_t)pn * 2 * hstep; u.i0 = pm; u.i1 = pn; u.i2 = 0; return true;
    }
    __device__ __forceinline__ unsigned row_off(const Unit&, int) const { return 0u; }
};

struct EpiIn {
    CParams P;
    __device__ __forceinline__ void operator()(const f32x4 (&acc)[2][2][4][2], const Unit& u, int wr, int wc, int fr, int fq) const {
        unsigned char* ws = relaunder(P)->ws;
        bf16_t* U = (bf16_t*)(ws + WS_U); bf16_t* QKV = (bf16_t*)(ws + WS_QH);
        const int pm = u.i0, pn = u.i1;
        const int row0 = pm * BM + wr * 64 + fr;
        if (pn < 8) {
            bf16_t* base = U + (size_t)row0 * DCONV + pn * 128 + wc * 32 + 8 * fq;
#pragma unroll
            for (int ai = 0; ai < 2; ++ai)
#pragma unroll
                for (int m = 0; m < 4; ++m) {
                    float r[8];
#pragma unroll
                    for (int n = 0; n < 2; ++n)
#pragma unroll
                        for (int i = 0; i < 4; ++i) { const float v = acc[ai][0][m][n][i], g = acc[ai][1][m][n][i]; r[4 * n + i] = v * __builtin_amdgcn_rcpf(1.f + __expf(-g)); }
                    v4u w; w.x = cvt_pk_bf16(r[0], r[1]); w.y = cvt_pk_bf16(r[2], r[3]); w.z = cvt_pk_bf16(r[4], r[5]); w.w = cvt_pk_bf16(r[6], r[7]);
                    bf16_t* dst = base + (size_t)(ai * HALF + m * 16) * DCONV;
                    asm volatile("global_store_dwordx4 %0, %1, off sc1\n\ts_nop 1" :: "v"(dst), "v"(w) : "memory");
                }
            asm volatile("s_waitcnt vmcnt(0)" ::: "memory");
            if ((threadIdx.x & 63) == 0) __hip_atomic_fetch_add((unsigned*)(ws + WS_CTL + CTL_UPAN) + 64 * pm, 1u, __ATOMIC_RELAXED, __HIP_MEMORY_SCOPE_AGENT);
        } else {
            const int which = (pn - 8) >> 2, hq = 4 * ((pn - 8) & 3) + (wc >> 1);
            const float sc = which == 0 ? QSCALE : 1.f;
            bf16_t* base = QKV + (size_t)which * ((size_t)NH * SEQ * HD) + (size_t)row0 * HD + (wc & 1) * 32 + 8 * fq;
#pragma unroll
            for (int ai = 0; ai < 2; ++ai)
#pragma unroll
                for (int m = 0; m < 4; ++m)
#pragma unroll
                    for (int bj = 0; bj < 2; ++bj) {
                        const f32x4 v0 = acc[ai][bj][m][0] * sc, v1 = acc[ai][bj][m][1] * sc;
                        v4u w; w.x = cvt_pk_bf16(v0[0], v0[1]); w.y = cvt_pk_bf16(v0[2], v0[3]); w.z = cvt_pk_bf16(v1[0], v1[1]); w.w = cvt_pk_bf16(v1[2], v1[3]);
                        *(v4u*)(base + ((size_t)(hq + 2 * bj) * SEQ + ai * HALF + m * 16) * HD) = w;
                    }
        }
    }
};
struct EpiOut {
    CParams P;
    __device__ __forceinline__ void operator()(const f32x4 (&acc)[2][2][4][2], const Unit& u, int wr, int wc, int fr, int fq) const {
        CParams Q = relaunder(P);
        const float* x = Q->x; unsigned char* ws = Q->ws;
        bf16_t* X1 = (bf16_t*)(ws + WS_X1); float* SSP = (float*)(ws + WS_SSP);
        const int pm = u.i0, pn = u.i1;
        const int row0 = pm * BM + wr * 64 + fr, col0 = pn * BM + wc * 32 + 8 * fq;
#pragma unroll
        for (int ai = 0; ai < 2; ++ai)
#pragma unroll
            for (int m = 0; m < 4; ++m) {
                const int row = row0 + ai * HALF + m * 16; const size_t off = (size_t)row * DM + col0;
                float q = 0.f;
#pragma unroll
                for (int bj = 0; bj < 2; ++bj) {
                    const f32x4 s0 = *(const f32x4*)(x + off + bj * HALF) + acc[ai][bj][m][0], s1 = *(const f32x4*)(x + off + bj * HALF + 4) + acc[ai][bj][m][1];
                    { v4u w1; w1.x = cvt_pk_bf16(s0[0], s0[1]); w1.y = cvt_pk_bf16(s0[2], s0[3]); w1.z = cvt_pk_bf16(s1[0], s1[1]); w1.w = cvt_pk_bf16(s1[2], s1[3]);
                      bf16_t* dst = X1 + off + bj * HALF; asm volatile("global_store_dwordx4 %0, %1, off sc1\n\ts_nop 1" :: "v"(dst), "v"(w1)); }
                    q += (s0[0] * s0[0] + s0[1] * s0[1]) + (s0[2] * s0[2] + s0[3] * s0[3]) + (s1[0] * s1[0] + s1[1] * s1[1]) + (s1[2] * s1[2] + s1[3] * s1[3]);
                }
                q += __shfl_xor(q, 16); q += __shfl_xor(q, 32);
                if (fq == 0) { float* dst = SSP + (size_t)(pn * 4 + wc) * SEQ + row; asm volatile("global_store_dword %0, %1, off sc1\n\ts_nop 1" :: "v"(dst), "v"(q)); }
            }
        asm volatile("s_waitcnt vmcnt(0)" ::: "memory");
        if ((threadIdx.x & 63) == 0) __hip_atomic_fetch_add((unsigned*)(ws + WS_CTL + CTL_RPAN) + 64 * pm, 1u, __ATOMIC_RELAXED, __HIP_MEMORY_SCOPE_AGENT);
    }
};
constexpr int TAB_TS = 0, TAB_OS = 65, TAB_CN = 130, TAB_SNAKE = 195, TAB_TI = 200;
}


#define XB_TMO      128
#define XB_XCNT(j)  (256  + 64 * (j))
#define XB_XSUB(j)  (1280 + 64 * (j))
#define XB_XGEN(j)  (2304 + 64 * (j))
#define XB_TOP      3328
#define XB_TOPGEN   3392
#define XCD_BAR_WORDS 3456
#define XB_SPIN_CAP (1u << 18)
__device__ __forceinline__ unsigned xb_ld(unsigned* p)              { return __hip_atomic_load(p, __ATOMIC_RELAXED, __HIP_MEMORY_SCOPE_AGENT); }
__device__ __forceinline__ unsigned xb_add(unsigned* p, unsigned v) { return __hip_atomic_fetch_add(p, v, __ATOMIC_RELAXED, __HIP_MEMORY_SCOPE_AGENT); }
__device__ __forceinline__ unsigned xb_xcc_id() { return (unsigned)__builtin_amdgcn_s_getreg((3 << 11) | 20) & 0xFu; }
#define XB_SPIN(cond, bar) do { unsigned _sp = 0; while (cond) { __builtin_amdgcn_s_sleep(1); \
    if ((++_sp & 255u) == 0u) { if (xb_ld(&(bar)[XB_TMO])) break; if (_sp > XB_SPIN_CAP) { atomicAdd(&(bar)[XB_TMO], 1u); break; } } } } while (0)
struct XcdBarrier { unsigned* bar; unsigned x; volatile LAS unsigned* st; bool norel; };
__device__ __forceinline__ XcdBarrier xcd_barrier_post(unsigned* bar, volatile LAS unsigned* st) {
    XcdBarrier b; b.bar = bar; b.x = xb_xcc_id(); b.st = st; b.norel = false;
    if (threadIdx.x == 0) (void)xb_add(&bar[XB_XCNT(b.x)], 1u);
    return b;
}
__device__ __forceinline__ void xcd_barrier_complete(unsigned* bar, unsigned x, unsigned& nloc, unsigned& nx) {
    const unsigned G = gridDim.x * gridDim.y * gridDim.z;
    unsigned sum, cnt, mine, sp = 0u;
    for (;;) {
        sum = 0u; cnt = 0u; mine = 0u;
#pragma unroll
        for (unsigned j = 0; j < 16; ++j) { const unsigned c = xb_ld(&bar[XB_XCNT(j)]); sum += c; cnt += (c > 0u) ? 1u : 0u; mine = (j == x) ? c : mine; }
        if (sum == G) break;
        __builtin_amdgcn_s_sleep(1);
        if ((++sp & 255u) == 0u) { if (xb_ld(&bar[XB_TMO])) break; if (sp > XB_SPIN_CAP) { atomicAdd(&bar[XB_TMO], 1u); break; } }
    }
    nloc = mine > 0u ? mine : 1u; nx = cnt > 0u ? cnt : 1u;
}
struct XbNoHook { __device__ __forceinline__ void operator()() const {} };
template <class F>
__device__ __forceinline__ void xcd_barrier_hook(const XcdBarrier& b, const F& hook) {
    asm volatile("s_waitcnt vmcnt(0)" ::: "memory");
    __syncthreads();
    if (threadIdx.x >= 64) hook();
    if (threadIdx.x == 0) {
        unsigned* bar = b.bar;
        __builtin_amdgcn_s_waitcnt(0);
        unsigned nloc = b.st[0], nx = b.st[1];
        if (nloc == 0u) { xcd_barrier_complete(bar, b.x, nloc, nx); b.st[0] = nloc; b.st[1] = nx; }
        const unsigned old = xb_add(&bar[XB_XSUB(b.x)], 1u);
        const unsigned gen = old / nloc;
        if (old + 1u == (gen + 1u) * nloc) {
            if (!b.norel) __builtin_amdgcn_fence(__ATOMIC_RELEASE, "agent");
            asm volatile("s_waitcnt vmcnt(0)" ::: "memory");
            const unsigned og = xb_add(&bar[XB_TOP], 1u);
            const unsigned tg = og / nx;
            if (og + 1u == (tg + 1u) * nx) xb_add(&bar[XB_TOPGEN], 1u);
            else XB_SPIN(xb_ld(&bar[XB_TOPGEN]) == tg, bar);
            xb_add(&bar[XB_XGEN(b.x)], 1u);
            __builtin_amdgcn_fence(__ATOMIC_ACQUIRE, "agent");
            asm volatile("s_waitcnt vmcnt(0)" ::: "memory");
        } else {
            XB_SPIN(xb_ld(&bar[XB_XGEN(b.x)]) == gen, bar);
            __builtin_amdgcn_fence(__ATOMIC_ACQUIRE, "agent");
            asm volatile("s_waitcnt vmcnt(0)" ::: "memory");
        }
    }
    __syncthreads();
}
__device__ __forceinline__ void xcd_barrier(const XcdBarrier& b) { xcd_barrier_hook(b, XbNoHook()); }


typedef short v4i16_t __attribute__((ext_vector_type(4)));
constexpr int ATT_BUF = 16384, ATT_V = 8192, ATT_BIAS = 8 * 16384;
__device__ __forceinline__ int crow(int r, int hi) { return (r & 3) + 8 * (r >> 2) + 4 * hi; }
__device__ __forceinline__ void attn_unit(CParams P, int h, int cg, LAS unsigned char* lds) {
    const int tid = threadIdx.x, lane = tid & 63, wave = __builtin_amdgcn_readfirstlane(tid >> 6), r32 = lane & 31, hi = lane >> 5;
    unsigned char* ws = P->ws;
    const bf16_t* Qh = (const bf16_t*)(ws + WS_QH) + (size_t)h * SEQ * HD; const bf16_t* Kh = (const bf16_t*)(ws + WS_KH) + (size_t)h * SEQ * HD;
    const bf16_t* Vh = (const bf16_t*)(ws + WS_VH) + (size_t)h * SEQ * HD; bf16_t* MIX = (bf16_t*)(ws + WS_MIX);
    const int c = cg * 8 + wave;
    LAS float* bias = (LAS float*)(lds + ATT_BIAS);
    __syncthreads();
    for (int i = tid; i < NREL; i += NTHR) bias[i] = P->rel_bias[h * NREL + i] * LOG2E;
    bf16x8 qf[2][4];
#pragma unroll
    for (int qb = 0; qb < 2; ++qb)
#pragma unroll
        for (int s = 0; s < 4; ++s) qf[qb][s] = *(const bf16x8*)(Qh + (size_t)(c * 64 + qb * 32 + r32) * HD + s * 16 + hi * 8);
#pragma unroll
    for (int qb = 0; qb < 2; ++qb)
#pragma unroll
        for (int s = 0; s < 4; ++s) asm volatile("" : "+v"(qf[qb][s]));
    float mrun[2] = {0.f, 0.f}, lrun[2] = {0.f, 0.f};
    f32x16 O[2][2];
#pragma unroll
    for (int a = 0; a < 2; ++a)
#pragma unroll
        for (int b = 0; b < 2; ++b)
#pragma unroll
            for (int r = 0; r < 16; ++r) O[a][b][r] = 0.f;
    const int T0 = cg * 8 - 8;
    const int skey = tid >> 3, sch = tid & 7;
    const bf16_t* Kg = Kh + (size_t)skey * HD + sch * 8; const bf16_t* Vg = Vh + (size_t)skey * HD + sch * 8;
    const int kwoff = skey * 128 + ((sch ^ (skey & 7)) << 4), vwoff = ATT_V + skey * 128 + (sch << 4);
    if (T0 >= 0) {
        v4u kr[8], vr[8];
#pragma unroll
        for (int i = 0; i < 8; ++i) { kr[i] = *(const v4u*)(Kg + (size_t)(T0 + i) * 64 * HD); vr[i] = *(const v4u*)(Vg + (size_t)(T0 + i) * 64 * HD); }
#pragma unroll
        for (int i = 0; i < 8; ++i) { *(LAS v4u*)(lds + i * ATT_BUF + kwoff) = kr[i]; *(LAS v4u*)(lds + i * ATT_BUF + vwoff) = vr[i]; }
    }
    __syncthreads();
    const int kroff = r32 * 128;
    const int vq = (lane & 15) >> 2, vp = lane & 3, vg1 = (lane >> 4) & 1;
    const int vroff = ATT_V + (4 * hi + vq) * 128 + (16 * vg1 + 4 * vp) * 2;
#pragma unroll 1
    for (int s = 0; s < 9; ++s) {
        const int tnew = T0 + 8 + (s < 8 ? s : 7);
        const v4u kreg = *(const v4u*)(Kg + (size_t)tnew * 64 * HD), vreg = *(const v4u*)(Vg + (size_t)tnew * 64 * HD);
        if (T0 + s + wave >= 0) {
            const int tt = s;
            LAS unsigned char* buf = lds + ((s + wave) & 7) * ATT_BUF;
            bf16x8 kf[2][4];
#pragma unroll
            for (int kh = 0; kh < 2; ++kh)
#pragma unroll
                for (int s = 0; s < 4; ++s) kf[kh][s] = *(const LAS bf16x8*)(buf + kh * 4096 + kroff + (((2 * s + hi) ^ (r32 & 7)) << 4));
            bf16x8 pb[2][2][2];
#pragma unroll
            for (int qb = 0; qb < 2; ++qb) {
                f32x16 S0, S1;
                const float nm = -mrun[qb];
                if (tt <= 5) { const float b = bias[2 * RCLIP] + nm;
#pragma unroll
                    for (int r = 0; r < 16; ++r) { S0[r] = b; S1[r] = b; } }
                else { const int base = LEFT * CHUNK - 64 * tt + qb * 32 + r32;
#pragma unroll
                    for (int r = 0; r < 16; ++r) { int d0 = base - crow(r, hi), d1 = d0 - 32;
                        d0 = d0 > RCLIP ? RCLIP : (d0 < -RCLIP ? -RCLIP : d0); d1 = d1 > RCLIP ? RCLIP : (d1 < -RCLIP ? -RCLIP : d1);
                        S0[r] = bias[d0 + RCLIP] + nm; S1[r] = bias[d1 + RCLIP] + nm; } }
#pragma unroll
                for (int s = 0; s < 4; ++s) { S0 = __builtin_amdgcn_mfma_f32_32x32x16_bf16(kf[0][s], qf[qb][s], S0, 0, 0, 0); S1 = __builtin_amdgcn_mfma_f32_32x32x16_bf16(kf[1][s], qf[qb][s], S1, 0, 0, 0); }
                float mx = __builtin_amdgcn_fmed3f(S0[0], S1[0], __builtin_inff());
#pragma unroll
                for (int r = 1; r < 16; ++r) mx = __builtin_amdgcn_fmed3f(__builtin_amdgcn_fmed3f(S0[r], S1[r], __builtin_inff()), mx, __builtin_inff());
                mx = __builtin_amdgcn_fmed3f(mx, __shfl_xor(mx, 32), __builtin_inff());
                if (__any(mx > 6.f)) {
                    const float dl = fmaxf(mx, 0.f), alpha = __builtin_amdgcn_exp2f(-dl);
                    mrun[qb] += dl; lrun[qb] *= alpha;
#pragma unroll
                    for (int r = 0; r < 16; ++r) { S0[r] -= dl; S1[r] -= dl; O[qb][0][r] *= alpha; O[qb][1][r] *= alpha; }
                }
                float rs = 0.f;
#pragma unroll
                for (int r = 0; r < 16; ++r) { S0[r] = __builtin_amdgcn_exp2f(S0[r]); S1[r] = __builtin_amdgcn_exp2f(S1[r]); rs += S0[r] + S1[r]; }
                rs += __shfl_xor(rs, 32);
                lrun[qb] += rs;
#pragma unroll
                for (int s2 = 0; s2 < 2; ++s2) {
                    v4u w0, w1;
                    w0.x = g8::cvt_pk_bf16(S0[8 * s2 + 0], S0[8 * s2 + 1]); w0.y = g8::cvt_pk_bf16(S0[8 * s2 + 2], S0[8 * s2 + 3]); w0.z = g8::cvt_pk_bf16(S0[8 * s2 + 4], S0[8 * s2 + 5]); w0.w = g8::cvt_pk_bf16(S0[8 * s2 + 6], S0[8 * s2 + 7]);
                    w1.x = g8::cvt_pk_bf16(S1[8 * s2 + 0], S1[8 * s2 + 1]); w1.y = g8::cvt_pk_bf16(S1[8 * s2 + 2], S1[8 * s2 + 3]); w1.z = g8::cvt_pk_bf16(S1[8 * s2 + 4], S1[8 * s2 + 5]); w1.w = g8::cvt_pk_bf16(S1[8 * s2 + 6], S1[8 * s2 + 7]);
                    pb[qb][0][s2] = __builtin_bit_cast(bf16x8, w0); pb[qb][1][s2] = __builtin_bit_cast(bf16x8, w1);
                }
            }
#pragma unroll
            for (int dh = 0; dh < 2; ++dh)
#pragma unroll
                for (int kh = 0; kh < 2; ++kh)
#pragma unroll
                    for (int s2 = 0; s2 < 2; ++s2) {
                        const LAS unsigned char* vp0 = buf + vroff + (32 * kh + 16 * s2) * 128 + 64 * dh;
                        const v4i16_t lo = __builtin_amdgcn_ds_read_tr16_b64_v4i16((LAS v4i16_t*)vp0);
                        const v4i16_t hv = __builtin_amdgcn_ds_read_tr16_b64_v4i16((LAS v4i16_t*)(vp0 + 8 * 128));
                        const bf16x8 vf = (bf16x8){lo[0], lo[1], lo[2], lo[3], hv[0], hv[1], hv[2], hv[3]};
                        O[0][dh] = __builtin_amdgcn_mfma_f32_32x32x16_bf16(vf, pb[0][kh][s2], O[0][dh], 0, 0, 0);
                        O[1][dh] = __builtin_amdgcn_mfma_f32_32x32x16_bf16(vf, pb[1][kh][s2], O[1][dh], 0, 0, 0);
                    }
        }
        if (s < 8) {
            __syncthreads();
            LAS unsigned char* nb = lds + (s & 7) * ATT_BUF; *(LAS v4u*)(nb + kwoff) = kreg; *(LAS v4u*)(nb + vwoff) = vreg;
            __syncthreads();
        }
    }
#pragma unroll
    for (int qb = 0; qb < 2; ++qb) {
        const float inv = 1.f / lrun[qb];
        bf16_t* orow = MIX + (size_t)(c * 64 + qb * 32 + r32) * DM + DCONV + h * HD + 4 * hi;
#pragma unroll
        for (int dh = 0; dh < 2; ++dh)
#pragma unroll
            for (int g = 0; g < 4; ++g) {
                v2u w; w.x = g8::cvt_pk_bf16(O[qb][dh][4 * g] * inv, O[qb][dh][4 * g + 1] * inv); w.y = g8::cvt_pk_bf16(O[qb][dh][4 * g + 2] * inv, O[qb][dh][4 * g + 3] * inv);
                *(v2u*)(orow + dh * 32 + 8 * g) = w;
            }
    }
}

constexpr int RT_RED = 0, RT_LOG = 8 * 32 * NRT * 4, RT_RS = RT_LOG + 32 * NRT * 4;
__device__ __forceinline__ void router_item(CParams P, int item, LAS unsigned char* lds) {
    const int tid = threadIdx.x, lane = tid & 63, wave = __builtin_amdgcn_readfirstlane(tid >> 6), fr = lane & 15, fq = lane >> 4;
    unsigned char* ws = P->ws;
    const bf16_t* X1 = (const bf16_t*)(ws + WS_X1); const float* SSP = (const float*)(ws + WS_SSP); const bf16_t* WrT = (const bf16_t*)(ws + WS_WRT);
    float* RSTD2 = (float*)(ws + WS_RSTD2); int* cnt = (int*)(ws + WS_CTL + CTL_CNT); int* ltk = (int*)(ws + WS_LTK); float* lgt = (float*)(ws + WS_LGT);
    const int row0 = item * 32;
    LAS float* red = (LAS float*)(lds + RT_RED); LAS float* lg = (LAS float*)(lds + RT_LOG); LAS float* rsl = (LAS float*)(lds + RT_RS);
    f32x4 acc[2][5];
#pragma unroll
    for (int rb = 0; rb < 2; ++rb)
#pragma unroll
        for (int cb = 0; cb < 5; ++cb) acc[rb][cb] = (f32x4){0.f, 0.f, 0.f, 0.f};
    const bf16_t* ap = X1 + (size_t)(row0 + fr) * DM + wave * 256 + fq * 8;
    const bf16_t* bp = WrT + (size_t)fr * DM + wave * 256 + fq * 8;
#pragma unroll
    for (int kh = 0; kh < 2; ++kh) {
        bf16x8 a[4][2], b[4][5];
#pragma unroll
        for (int k4 = 0; k4 < 4; ++k4) {
#pragma unroll
            for (int rb = 0; rb < 2; ++rb) a[k4][rb] = *(const bf16x8*)(ap + (size_t)rb * 16 * DM + (kh * 4 + k4) * 32);
#pragma unroll
            for (int cb = 0; cb < 5; ++cb) b[k4][cb] = *(const bf16x8*)(bp + (size_t)cb * 16 * DM + (kh * 4 + k4) * 32);
        }
#pragma unroll
        for (int k4 = 0; k4 < 4; ++k4)
#pragma unroll
            for (int rb = 0; rb < 2; ++rb)
#pragma unroll
                for (int cb = 0; cb < 5; ++cb) acc[rb][cb] = __builtin_amdgcn_mfma_f32_16x16x32_bf16(a[k4][rb], b[k4][cb], acc[rb][cb], 0, 0, 0);
    }
    __syncthreads();
#pragma unroll
    for (int rb = 0; rb < 2; ++rb)
#pragma unroll
        for (int cb = 0; cb < 5; ++cb)
#pragma unroll
            for (int i = 0; i < 4; ++i) red[(wave * 32 + rb * 16 + 4 * fq + i) * NRT + cb * 16 + fr] = acc[rb][cb][i];
    {
        LAS float* ssl = (LAS float*)(lds + RT_RS + 256);
        if (tid < 64) { float s2 = 0.f;
#pragma unroll
            for (int i = 0; i < 16; ++i) s2 += SSP[(size_t)((tid >> 5) * 16 + i) * SEQ + row0 + (tid & 31)];
            ssl[tid] = s2; }
    }
    __syncthreads();
    if (tid < 32) {
        const LAS float* ssl = (const LAS float*)(lds + RT_RS + 256);
        const float rstd = rsqrtf((ssl[tid] + ssl[32 + tid]) * (1.f / DM) + 1e-6f);
        { float* d_ = RSTD2 + row0 + tid; asm volatile("global_store_dword %0, %1, off sc1\n\ts_nop 1" :: "v"(d_), "v"(rstd)); } rsl[tid] = rstd;
    }
    for (int idx = tid; idx < 32 * NRT; idx += NTHR) {
        float s = 0.f;
#pragma unroll
        for (int w = 0; w < NWAVES; ++w) s += red[w * 32 * NRT + idx];
        lg[idx] = s;
    }
    __syncthreads();
    if (tid < 32) {
        const int t = row0 + tid; const float rstd = rsl[tid]; const LAS float* L = lg + tid * NRT;
        const float* bg = P->b_group; const float* be = P->b_er;
        float gmax = -INFINITY; int grp = 0; float glv[NG];
#pragma unroll
        for (int g = 0; g < NG; ++g) { glv[g] = L[g] * rstd + bg[g]; if (glv[g] > gmax) { gmax = glv[g]; grp = g; } }
        float sum = 0.f;
#pragma unroll
        for (int g = 0; g < NG; ++g) sum += __expf(glv[g] - gmax);
        const float pgrp = 1.f / sum;
        float v0 = -INFINITY, v1 = -INFINITY; int i0 = 0, i1 = 0;
        for (int i = 0; i < EPG; ++i) {
            const float v = L[NG + grp * EPG + i] * rstd + be[grp * EPG + i];
            if (v > v0) { v1 = v0; i1 = i0; v0 = v; i0 = i; } else if (v > v1) { v1 = v; i1 = i; }
        }
        const float e1 = __expf(v1 - v0), inv = 1.f / (1.f + e1);
        const int ea = grp * EPG + i0, eb = grp * EPG + i1;
        float* lrs = (float*)(ws + WS_LRS);
#define RT_ST(ptr_, val_) do { auto* d_ = (ptr_); const auto v_ = (val_); asm volatile("global_store_dword %0, %1, off sc1\n\ts_nop 1" :: "v"(d_), "v"(v_)); } while (0)
        const int sa = atomicAdd(&cnt[ea * CNT_STRIDE], 1); RT_ST(ltk + ea * LCAP + sa, t * 2 + 0); RT_ST(lgt + ea * LCAP + sa, inv * pgrp); RT_ST(lrs + ea * LCAP + sa, rstd);
        const int sb = atomicAdd(&cnt[eb * CNT_STRIDE], 1); RT_ST(ltk + eb * LCAP + sb, t * 2 + 1); RT_ST(lgt + eb * LCAP + sb, e1 * inv * pgrp); RT_ST(lrs + eb * LCAP + sb, rstd);
#undef RT_ST
    }
}

__device__ __forceinline__ void moe_build_table(CParams P, LAS unsigned char* lds) {
    LAS int* tab = (LAS int*)(lds + LDS_TAB);
    __syncthreads();
    if (threadIdx.x < 64) {
        const int e = threadIdx.x;
        int* cnt = (int*)(P->ws + WS_CTL + CTL_CNT);
        const int c = __hip_atomic_load(cnt + e * CNT_STRIDE, __ATOMIC_RELAXED, __HIP_MEMORY_SCOPE_AGENT);
        const int n = (c + MTR - 1) / MTR;
        int ts = n, os = c, ov = n > 1 ? n - 1 : 0;
#pragma unroll
        for (int o = 1; o < 64; o <<= 1) { const int a_ = __shfl_up(ts, o), b_ = __shfl_up(os, o), c_ = __shfl_up(ov, o); if (e >= o) { ts += a_; os += b_; ov += c_; } }
        tab[g8::TAB_TS + e] = ts - n; tab[g8::TAB_OS + e] = os - c; tab[g8::TAB_CN + e] = c;
        if (e == 63) { tab[g8::TAB_TS + NE] = ts; tab[g8::TAB_OS + NE] = os; }
        int rank = 0; bool all_pos = true;
        for (int o = 0; o < 64; ++o) { const int co = __shfl(c, o); rank += (co > c || (co == c && o < e)) ? 1 : 0; all_pos = all_pos && co > 0; }
        if (all_pos) {
            if (n > 0) tab[g8::TAB_TI + rank] = (e << 8);
            for (int m = 1; m < n; ++m) tab[g8::TAB_TI + NE + (ov - (n - 1)) + m - 1] = (e << 8) | m;
        } else {
            for (int m = 0; m < n; ++m) tab[g8::TAB_TI + (ts - n) + m] = (e << 8) | m;
        }
        if (e == 0) tab[g8::TAB_SNAKE] = all_pos ? 1 : 0;
    }
    __syncthreads();
}
template <int NT, bool SNAKE>
__device__ __forceinline__ int moe_tile_of(const LAS int* tab, int L, int G) {
    if (SNAKE && tab[g8::TAB_SNAKE] && G == 256 && L < NE * NT) { const int tpr = 256 / NT, i = L >> 8, q = (L & 255) / NT; return i * tpr + ((i & 1) ? tpr - 1 - q : q); }
    return L / NT;
}

namespace m9 {
constexpr int SLOT = 16384;
#define M9_BAR() do { asm volatile("s_waitcnt lgkmcnt(0)" ::: "memory"); __builtin_amdgcn_s_barrier(); asm volatile("" ::: "memory"); } while (0)
template <bool DOWN>
__device__ __forceinline__ void moe_phase(CParams P, const int first, const int step, const int nunits, const int G, LAS unsigned char* lds) {
    const int tid = threadIdx.x, wid = __builtin_amdgcn_readfirstlane(tid >> 6), lane = tid & 63, fr = lane & 15, fq = lane >> 4;
    const LAS int* tab = (const LAS int*)(lds + LDS_TAB);
    unsigned char* ws = P->ws;
    constexpr int NT = DOWN ? 16 : 8, K = DOWN ? DE : DM, NKT = K / 64, ldb = DOWN ? DM : DE;
    if (first >= nunits) return;
    volatile LAS int* uq = (volatile LAS int*)(lds + LDS_MISC + 128);
    const int nmine = DOWN ? 0 : (nunits - first + step - 1) / step;
    const int total6 = (nmine * NKT + 5) / 6 * 6;
#define M9_NM() (DOWN ? uq[16] : nmine)
#define M9_UNIT(j_) (DOWN ? ((j_) == 0 ? first : uq[(j_) & 15]) : first + (j_) * step)
    LAS float* g2s = (LAS float*)(lds + 2 * SLOT);
    if (!DOWN) { __syncthreads(); for (int i = tid; i < DM; i += NTHR) g2s[i] = P->norm2_g[i]; __syncthreads(); }
    if (wid >= 6) {
        const int pw = wid - 6, nq = DOWN ? (lane & 31) : (lane & 15), kg = DOWN ? (lane >> 5) : (lane >> 4);
        const int krow0 = DOWN ? 32 * pw + 16 * kg : 16 * kg;
        const int col0 = DOWN ? 32 * ((4 * nq) >> 5) + 16 * (nq & 1) + 4 * ((nq >> 1) & 3) : 32 * ((4 * nq) >> 4) + 16 * pw + ((4 * nq) & 15);
        const int wbase = krow0 * 256, c2 = 2 * col0;
        const unsigned voff = (unsigned)(krow0 * ldb + 4 * nq) * 4u;
        int qu = 0, qt = 0; const char* Bq;
#define M9_QPTR() do { const int nmq_ = M9_NM(); const int Lq_ = M9_UNIT(qu < nmq_ ? qu : nmq_ - 1); const int Tq_ = moe_tile_of<NT, !DOWN>(tab, Lq_, G), ntq_ = Lq_ % NT; const int eq_ = __builtin_amdgcn_readfirstlane(tab[g8::TAB_TI + Tq_]) >> 8; \
        if (DOWN) Bq = (const char*)(P->w_down + (size_t)eq_ * DE * DM + 128 * ntq_); \
        else Bq = (const char*)((pw ? P->w_up : P->w_gate) + (size_t)eq_ * DM * DE + 64 * ntq_); } while (0)
        M9_QPTR();
        f32x4 rb[1][16];
#define M9_BLOAD(set) do { const char* s_ = Bq + (size_t)(qu < M9_NM() ? qt : 0) * (64 * ldb * 4); _Pragma("unroll") for (int j_ = 0; j_ < 16; ++j_) rb[set][j_] = *(const f32x4*)(s_ + (size_t)j_ * (ldb * 4) + voff); \
        if (++qt == NKT) { qt = 0; ++qu; M9_QPTR(); } } while (0)
        int wtile = 0;
#define M9_BWRITE(set, sl) do { LAS unsigned char* d_ = lds + (sl) * SLOT + wbase; f32x4 gq_[4]; \
        if (!DOWN) { _Pragma("unroll") for (int q_ = 0; q_ < 4; ++q_) gq_[q_] = *(const LAS f32x4*)(g2s + wtile * 64 + krow0 + 4 * q_); if (++wtile == NKT) wtile = 0; } \
        _Pragma("unroll") for (int j_ = 0; j_ < 16; ++j_) { v2u x_; const float gj_ = DOWN ? 1.f : gq_[j_ >> 2][j_ & 3]; \
        x_.x = g8::cvt_pk_bf16(rb[set][j_][0] * gj_, rb[set][j_][1] * gj_); x_.y = g8::cvt_pk_bf16(rb[set][j_][2] * gj_, rb[set][j_][3] * gj_); *(LAS v2u*)(d_ + j_ * 256 + (c2 ^ (((j_ & 3) + 4 * ((j_ >> 3) & 1)) << 5))) = x_; } } while (0)
        M9_BLOAD(0);
        M9_BWRITE(0, 0);
        M9_BLOAD(0);
        M9_BAR();
#define M9_PSTEP(set, sl) do { M9_BWRITE(set, sl); M9_BLOAD(set); M9_BAR(); } while (0)
#pragma unroll 1
        for (int s = 0; DOWN ? (s >> 3) < uq[16] : s < total6; s += 6) {
            M9_PSTEP(0, 1); M9_PSTEP(0, 0); M9_PSTEP(0, 1); M9_PSTEP(0, 0); M9_PSTEP(0, 1); M9_PSTEP(0, 0);
        }
#undef M9_QPTR
#undef M9_BLOAD
#undef M9_BWRITE
#undef M9_PSTEP
    } else {
        const int* ltk = (const int*)(ws + WS_LTK);
        const char* Ab = (const char*)ws + (DOWN ? WS_HM : WS_X1);
        const int tq = fr >> 2, tp = fr & 3;
        const int rrow = (8 * fq + tq) * 256 + 8 * tp, thx = (tq + 4 * (fq & 1)) << 5;
#define M9_DECODE(L_, e_, mt_, nt_, ce_, ob_) do { const int T_ = moe_tile_of<NT, !DOWN>(tab, (L_), G); nt_ = (L_) % NT; const int ti_ = __builtin_amdgcn_readfirstlane(tab[g8::TAB_TI + T_]); e_ = ti_ >> 8; mt_ = ti_ & 255; \
        ce_ = __builtin_amdgcn_readfirstlane(tab[g8::TAB_CN + e_]); ob_ = __builtin_amdgcn_readfirstlane(tab[g8::TAB_OS + e_]); } while (0)
#define M9_IDX(m_, mt_, ce_) ({ int i_ = (mt_) * MTR + 16 * (wid + 6 * (m_)) + fr; i_ < (ce_) ? i_ : (ce_) - 1; })
#define M9_OFF(raw_) ((DOWN ? (unsigned)(raw_) * (unsigned)(DE * 2) : (unsigned)((raw_) >> 1) * (unsigned)(DM * 2)) + (unsigned)fq * 16u)
#define M9_RAW(m_, e_, mt_, ce_, ob_) (DOWN ? (ob_) + M9_IDX(m_, mt_, ce_) : ltk[(e_) * LCAP + M9_IDX(m_, mt_, ce_)])
#define M9_WAIT(e_, mt_, ce_) do { if (DOWN && (mt_) >= 1) { unsigned* c_ = (unsigned*)(ws + WS_CTL + CTL_UPC) + 64 * (e_); const unsigned want_ = (unsigned)(((ce_) + MTR - 1) / MTR - 1) * 48u; unsigned sp_ = 0; \
            while ((unsigned)__builtin_amdgcn_readfirstlane(__hip_atomic_load(c_, __ATOMIC_RELAXED, __HIP_MEMORY_SCOPE_AGENT)) < want_) { __builtin_amdgcn_s_sleep(8); if (++sp_ > (1u << 22)) break; } \
            __builtin_amdgcn_fence(__ATOMIC_ACQUIRE, "agent"); asm volatile("s_waitcnt vmcnt(0)" ::: "memory"); } } while (0)
        int L = first, ju = 0;
        unsigned* qhead = (unsigned*)(ws + WS_CTL + CTL_DOWNQ);
        int e, mt, nt, ce, ob; M9_DECODE(L, e, mt, nt, ce, ob);
        M9_WAIT(e, mt, ce);
        unsigned aro[3];
#pragma unroll
        for (int m = 0; m < 3; ++m) aro[m] = M9_OFF(M9_RAW(m, e, mt, ce, ob));
        unsigned aro3 = M9_OFF(M9_RAW(3, e, mt, ce, ob));
        f32x4 acc[4][8];
#pragma unroll
        for (int m = 0; m < 4; ++m)
#pragma unroll
            for (int n = 0; n < 8; ++n) acc[m][n] = (f32x4){0.f, 0.f, 0.f, 0.f};
        bf16x8 A0[3][2], A1[3][2], A3[2];
#define M9_ALOAD(dst, t) do { const unsigned to_ = (unsigned)(t) * 128u; _Pragma("unroll") for (int m_ = 0; m_ < 3; ++m_) _Pragma("unroll") for (int k_ = 0; k_ < 2; ++k_) \
            dst[m_][k_] = *(const bf16x8*)(Ab + aro[m_] + to_ + k_ * 64); } while (0)
#define M9_BFRAG(dst, sl, nb_, ks_) do { const LAS unsigned char* p_ = lds + (sl) * SLOT + (rrow + (((nb_) << 5) ^ thx)) + (ks_) * 8192; \
            const v4i16_t lo_ = __builtin_amdgcn_ds_read_tr16_b64_v4i16((LAS v4i16_t*)p_); const v4i16_t hi_ = __builtin_amdgcn_ds_read_tr16_b64_v4i16((LAS v4i16_t*)(p_ + 1024)); \
            dst = (bf16x8){lo_[0], lo_[1], lo_[2], lo_[3], hi_[0], hi_[1], hi_[2], hi_[3]}; } while (0)
#define M9_COMPUTE(Acur, sl) do { _Pragma("unroll") for (int nb_ = 0; nb_ < 8; ++nb_) { bf16x8 b0_, b1_; M9_BFRAG(b0_, sl, nb_, 0); M9_BFRAG(b1_, sl, nb_, 1); \
            _Pragma("unroll") for (int m_ = 0; m_ < 2; ++m_) { acc[m_][nb_] = __builtin_amdgcn_mfma_f32_16x16x32_bf16(b0_, Acur[m_][0], acc[m_][nb_], 0, 0, 0); \
                acc[m_][nb_] = __builtin_amdgcn_mfma_f32_16x16x32_bf16(b1_, Acur[m_][1], acc[m_][nb_], 0, 0, 0); } \
            if (three) { acc[2][nb_] = __builtin_amdgcn_mfma_f32_16x16x32_bf16(b0_, Acur[2][0], acc[2][nb_], 0, 0, 0); \
                acc[2][nb_] = __builtin_amdgcn_mfma_f32_16x16x32_bf16(b1_, Acur[2][1], acc[2][nb_], 0, 0, 0); } \
            if (four) { acc[3][nb_] = __builtin_amdgcn_mfma_f32_16x16x32_bf16(b0_, A3[0], acc[3][nb_], 0, 0, 0); \
                acc[3][nb_] = __builtin_amdgcn_mfma_f32_16x16x32_bf16(b1_, A3[1], acc[3][nb_], 0, 0, 0); } } } while (0)
#define M9_A3LOAD(t) do { if (four) { const char* s3_ = Ab + aro3 + (unsigned)(t) * 128u; A3[0] = *(const bf16x8*)s3_; A3[1] = *(const bf16x8*)(s3_ + 64); } } while (0)
        M9_ALOAD(A0, 0);
        M9_BAR();
        for (;;) {
            const bool three = 16 * (wid + 12) < min(ce - mt * MTR, MTR), four = 16 * (wid + 18) < min(ce - mt * MTR, MTR);
            int Ln = L + step; bool has_next = Ln < nunits;
            int e2, mt2, nt2, ce2, ob2;
            int qnext = 0;
            if (DOWN) {
                if (wid == 0 && lane == 0) {
                    const int xq = uq[17];
                    if (xq < 0) qnext = step + (int)__hip_atomic_fetch_add(qhead, 1u, __ATOMIC_RELAXED, __HIP_MEMORY_SCOPE_AGENT);
                    else {
                        const int u = uq[18] + (int)__hip_atomic_fetch_add((unsigned*)(ws + WS_CTL + CTL_LQ) + 64 * xq, 1u, __ATOMIC_RELAXED, __HIP_MEMORY_SCOPE_AGENT);
                        if (u < NE * 2) qnext = (xq + 8 * (u >> 4)) * 16 + (u & 15);
                        else qnext = NE * 16 + (int)__hip_atomic_fetch_add(qhead, 1u, __ATOMIC_RELAXED, __HIP_MEMORY_SCOPE_AGENT);
                    }
                }
                e2 = e; mt2 = mt; nt2 = nt; ce2 = ce; ob2 = ob; }
            else M9_DECODE(has_next ? Ln : L, e2, mt2, nt2, ce2, ob2);
            int rtn[4]; float eg[4]; int etk[4];
#pragma unroll
            for (int m = 0; m < 4; ++m) {
                const int i1 = M9_IDX(m, mt, ce);
                rtn[m] = DOWN ? 0 : M9_RAW(m, e2, mt2, ce2, ob2);
                if (DOWN) { etk[m] = ltk[e * LCAP + i1]; eg[m] = ((const float*)(ws + WS_LGT))[e * LCAP + i1]; }
                else { etk[m] = 0; eg[m] = ((const float*)(ws + WS_LRS))[e * LCAP + i1]; }
            }
#pragma unroll 1
            for (int t2 = 0; t2 < NKT; t2 += 2) {
                if (DOWN && t2 == 2 && wid == 0 && lane == 0) { if (qnext < nunits) uq[(ju + 1) & 15] = qnext; else uq[16] = ju + 1; }
                M9_A3LOAD(t2); M9_ALOAD(A1, t2 + 1); __builtin_amdgcn_sched_barrier(0);
                M9_COMPUTE(A0, 0);
                M9_BAR();
                M9_A3LOAD(t2 + 1);
                if (t2 == NKT - 2) {
                    if (DOWN) { has_next = ju + 1 < uq[16]; if (has_next) { Ln = uq[(ju + 1) & 15]; M9_DECODE(Ln, e2, mt2, nt2, ce2, ob2); }
#pragma unroll
                        for (int m = 0; m < 4; ++m) rtn[m] = M9_RAW(m, e2, mt2, ce2, ob2); }
                    if (has_next) M9_WAIT(e2, mt2, ce2);
#pragma unroll
                    for (int m = 0; m < 3; ++m) aro[m] = M9_OFF(rtn[m]);
                    M9_ALOAD(A0, 0);
                } else M9_ALOAD(A0, t2 + 2);
                __builtin_amdgcn_sched_barrier(0);
                M9_COMPUTE(A1, 1);
                M9_BAR();
            }
            aro3 = M9_OFF(rtn[3]);
#pragma unroll
            for (int m = 0; m < 4; ++m) {
                const int idx = mt * MTR + 16 * (wid + 6 * m) + fr;
                if (idx < ce) {
                    if (DOWN) {
                        bf16_t* rowp = (bf16_t*)(ws + WS_Y) + (size_t)etk[m] * DM + nt * 128 + 8 * fq;
#pragma unroll
                        for (int s = 0; s < 4; ++s) { const f32x4 v0 = acc[m][2 * s] * eg[m], v1 = acc[m][2 * s + 1] * eg[m]; v4u w;
                            w.x = g8::cvt_pk_bf16(v0[0], v0[1]); w.y = g8::cvt_pk_bf16(v0[2], v0[3]); w.z = g8::cvt_pk_bf16(v1[0], v1[1]); w.w = g8::cvt_pk_bf16(v1[2], v1[3]); *(v4u*)(rowp + 32 * s) = w; }
                    } else {
                        bf16_t* rowp = (bf16_t*)(ws + WS_HM) + (size_t)(ob + idx) * DE + nt * 64 + 4 * fq; const float rs = eg[m];
#pragma unroll
                        for (int j = 0; j < 4; ++j) {
                            float h[4];
#pragma unroll
                            for (int i = 0; i < 4; ++i) { const float g = acc[m][2 * j][i] * rs, uu = acc[m][2 * j + 1][i] * rs; h[i] = g * __builtin_amdgcn_rcpf(1.f + __expf(-g)) * uu; }
                            v2u w; w.x = g8::cvt_pk_bf16(h[0], h[1]); w.y = g8::cvt_pk_bf16(h[2], h[3]);
                            if (mt >= 1) { bf16_t* dst = rowp + 16 * j; asm volatile("global_store_dwordx2 %0, %1, off sc1\n\ts_nop 1" :: "v"(dst), "v"(w)); }
                            else *(v2u*)(rowp + 16 * j) = w;
                        }
                    }
                }
            }
            if (!DOWN && mt >= 1) {
                asm volatile("s_waitcnt vmcnt(0)" ::: "memory");
                if (lane == 0) __hip_atomic_fetch_add((unsigned*)(ws + WS_CTL + CTL_UPC) + 64 * e, 1u, __ATOMIC_RELAXED, __HIP_MEMORY_SCOPE_AGENT);
            }
            if (!has_next) break;
            L = Ln; e = e2; mt = mt2; nt = nt2; ce = ce2; ob = ob2; ++ju;
#pragma unroll
            for (int m = 0; m < 4; ++m)
#pragma unroll
                for (int n = 0; n < 8; ++n) acc[m][n] = (f32x4){0.f, 0.f, 0.f, 0.f};
        }
        { const int nm_ = DOWN ? ju + 1 : nmine; for (int s = nm_ * NKT; s < (nm_ * NKT + 5) / 6 * 6; ++s) M9_BAR(); }
#undef M9_DECODE
#undef M9_NM
#undef M9_UNIT
#undef M9_IDX
#undef M9_OFF
#undef M9_RAW
#undef M9_WAIT
#undef M9_ALOAD
#undef M9_A3LOAD
#undef M9_BFRAG
#undef M9_COMPUTE
    }
}
#undef M9_BAR
}
constexpr int LDS_BYTES = 147456;
__global__ void __launch_bounds__(NTHR, 2) mega(Params p_kernarg) {
    extern __shared__ __attribute__((aligned(16))) unsigned char lds_raw[];
    LAS unsigned char* lds = (LAS unsigned char*)lds_raw;
    const int G = gridDim.x, bx = blockIdx.x;
    const int vcu = (G % 8 == 0) ? (bx % 8) * (G / 8) + bx / 8 : bx;
    CParams P = kparams();
    const int lo = P->ph_lo, hi = P->ph_hi;
#define IN(k) (lo <= (k) && (k) < hi)
#define BOTH(k) (IN(k) && IN((k) + 1))
    volatile LAS unsigned* misc = (volatile LAS unsigned*)(lds + LDS_MISC);
    if (threadIdx.x < 32) misc[threadIdx.x] = 0u;
    __syncthreads();
    XcdBarrier bar; bar.bar = (unsigned*)(P->ws + WS_CTL) + P->li * XCD_BAR_WORDS; bar.x = 0; bar.st = misc + 8; bar.norel = false;
    if (hi - lo > 1) bar = xcd_barrier_post(bar.bar, misc + 8);
#define GRID_BAR(k) do { if (BOTH(k)) xcd_barrier(bar); } while (0)
    if (IN(0)) { phase_prologue(kparams(), vcu, G, lds); GRID_BAR(0); }
    if (IN(1)) {
        g8::InOrder S; S.init(P->ws + WS_HB, P->ws + WS_WINT, DM, G, vcu);
        g8::EpiIn E{P};
        g8::gemm_phase<g8::EpiIn, g8::InOrder, false>(lds, DM, (size_t)g8::HALF * DM * 2, (size_t)g8::HALF * DM * 2, S, E);
        wout_queue(kparams(), lds);
        conv_queue(kparams(), lds);
        GRID_BAR(1);
    }
    if (IN(2)) {
        for (int u = vcu; u < NH * (SEQ / 512); u += G) attn_unit(kparams(), u >> 4, u & 15, lds);
        GRID_BAR(2);
    }
    if (IN(3)) {
        g8::DenseOrder S; S.init(P->ws + WS_MIX, P->ws + WS_WOUTT, SEQ, DM, DM, G, bx);
        g8::EpiOut E{P};
        g8::gemm_phase<g8::EpiOut, g8::DenseOrder, false>(lds, DM, (size_t)g8::HALF * DM * 2, (size_t)g8::HALF * DM * 2, S, E);
    }
    if (IN(4)) {
        g8::DenseOrder S; S.init(P->ws + WS_MIX, P->ws + WS_WOUTT, SEQ, DM, DM, G, bx);
        g8::Unit u;
        for (int i = 0; S.next(i, u); ++i) {
            const int pm = u.i0, it = 8 * u.i0 + u.i1;
            __syncthreads();
            if (threadIdx.x < 64) {
                const unsigned* c = (const unsigned*)(kparams()->ws + WS_CTL + CTL_RPAN) + 64 * pm; unsigned spins = 0;
                while ((unsigned)__builtin_amdgcn_readfirstlane(__hip_atomic_load(c, __ATOMIC_RELAXED, __HIP_MEMORY_SCOPE_AGENT)) < 64u) { __builtin_amdgcn_s_sleep(8); if (++spins > (1u << 22)) break; }
                __builtin_amdgcn_fence(__ATOMIC_ACQUIRE, "agent");
                asm volatile("s_waitcnt vmcnt(0)" ::: "memory");
            }
            __syncthreads();
            router_item(kparams(), it, lds);
        }
        if (BOTH(4)) { bar.norel = true; xcd_barrier(bar); bar.norel = false; }
    }
    if (IN(5) || IN(6)) {
        moe_build_table(kparams(), lds);
        const LAS int* tab = (const LAS int*)(lds + LDS_TAB);
        const int ntiles = tab[g8::TAB_TS + NE], snake = tab[g8::TAB_SNAKE];
        const int nov = (snake && G == 256) ? ntiles - NE : 0;
        const int nres = nov * 8 < G / 4 ? nov * 8 : G / 4;
        const int ru_up = (ntiles - nov) * 8;
        if (IN(5)) {
            m9::moe_phase<false>(kparams(), vcu, G, ru_up, G, lds);
            struct PfHook { CParams P; const LAS int* tab; int nov, G, bx;
                __device__ __forceinline__ void operator()() const {
                    for (int o = 0; o < (nov < 4 ? nov : 4); ++o) {
                        const int e = tab[g8::TAB_TI + NE + o] >> 8;
                        const f32x4* pg = (const f32x4*)(P->w_gate + (size_t)e * DM * DE); const f32x4* pu = (const f32x4*)(P->w_up + (size_t)e * DM * DE);
                        for (int i = bx * 448 + ((int)threadIdx.x - 64); i < DM * DE / 4; i += G * 448) { (void)*(volatile const f32x4*)(pg + i); (void)*(volatile const f32x4*)(pu + i); }
                    }
                } };
            if (BOTH(5)) xcd_barrier_hook(bar, PfHook{kparams(), tab, nres > 0 ? nov : 0, G, bx});
        }
        if (IN(6)) {
            const bool lq = snake && G == 256 && nov <= 8;
            const int slot = vcu & 31, xc = vcu >> 5;
            const bool resv = lq ? slot >= 32 - nov : (nres > 0 && vcu >= G - nres);
            if (resv) m9::moe_phase<false>(kparams(), ru_up + (lq ? xc + 8 * (slot - (32 - nov)) : vcu - (G - nres)), nres, ntiles * 8, G, lds);
            else {
                const int first = lq ? (xc + 8 * (slot >> 4)) * 16 + (slot & 15) : vcu;
                if (threadIdx.x == 0) { volatile LAS int* uq = (volatile LAS int*)(lds + LDS_MISC + 128); uq[0] = first; uq[16] = 0x7fffffff; uq[17] = lq ? xc : -1; uq[18] = 32 - nov; }
                __syncthreads();
                m9::moe_phase<true>(kparams(), first, G - nres, ntiles * 16, G, lds);
            }
            GRID_BAR(6);
        }
    }
    if (IN(7)) phase_final(kparams(), vcu, G);
#undef IN
#undef BOTH
#undef GRID_BAR
}

extern "C" void kernel_launch(void* const* d_in, const int* in_sizes, int n_in, void* d_out, int out_size, void* d_ws, size_t ws_size, hipStream_t stream) {
    static int grid = 0;
    if (grid == 0) {
        if (ws_size < WS_END) { fprintf(stderr, "kernel_launch: workspace too small (%zu < %zu)\n", ws_size, (size_t)WS_END); grid = -1; return; }
        int dev = 0, cus = 0, per_cu = 0;
        (void)hipGetDevice(&dev); (void)hipDeviceGetAttribute(&cus, hipDeviceAttributeMultiprocessorCount, dev);
        (void)hipFuncSetAttribute((const void*)mega, hipFuncAttributeMaxDynamicSharedMemorySize, LDS_BYTES);
        (void)hipOccupancyMaxActiveBlocksPerMultiprocessor(&per_cu, (const void*)mega, NTHR, LDS_BYTES);
        if (per_cu < 1) { fprintf(stderr, "kernel_launch: occupancy query says %d blocks per CU\n", per_cu); grid = -1; return; }
        grid = cus;
    }
    if (grid < 0) return;
    Params p{};
    p.x = (const float*)d_in[0]; p.norm1_g = (const float*)d_in[1]; p.w_in = (const float*)d_in[2]; p.w_dw = (const float*)d_in[3]; p.b_dw = (const float*)d_in[4];
    p.ln_g = (const float*)d_in[5]; p.ln_b = (const float*)d_in[6]; p.rel_bias = (const float*)d_in[7]; p.w_out = (const float*)d_in[8]; p.norm2_g = (const float*)d_in[9];
    p.w_group = (const float*)d_in[10]; p.b_group = (const float*)d_in[11]; p.w_er = (const float*)d_in[12]; p.b_er = (const float*)d_in[13];
    p.w_gate = (const float*)d_in[14]; p.w_up = (const float*)d_in[15]; p.w_down = (const float*)d_in[16]; p.final_g = (const float*)d_in[17];
    p.out = (float*)d_out; p.ws = (unsigned char*)d_ws;
    unsigned char* ws = (unsigned char*)d_ws;
    (void)hipMemsetAsync(ws + WS_CTL, 0, CTL_BYTES, stream);
    p.ph_lo = 0; p.ph_hi = 8; p.li = 0; p.pad = 0;
    hipLaunchKernelGGL(mega, dim3(grid), dim3(NTHR), LDS_BYTES, stream, p);
}
```
